# Optimizing an MI355X kernel written in HIP

```python
import math
import jax, jax.numpy as jnp
from jax import lax
import numpy as np

D_MODEL = 1024
BATCH = 2
SEQ = 8192
DEPTH = 2

CHUNK = 64
D_MIX = D_MODEL
D_SSM = D_MIX // 2
D_MLSTM = D_MIX - D_SSM
SSM_GROUP = 16
SSM_GROUPS = D_SSM // SSM_GROUP
SSM_STATE = 64
ML_HEADS = 4
ML_HEAD_DIM = D_MLSTM // ML_HEADS
CONV_WIDTH = 4
D_FF = 4 * D_MODEL
D_IN = D_SSM + 4 * D_MLSTM + 2 * ML_HEADS
EPS = 1e-6
DT_MIN = 1e-3
DT_MAX = 1e-1

kernel_name = "hybrid_s5_mlstm_parallel_heads"


def rmsnorm(x, g):
    xf = x.astype(jnp.float32)
    y = xf * lax.rsqrt(jnp.mean(jnp.square(xf), axis=-1, keepdims=True) + EPS)
    return (y * g.astype(jnp.float32)).astype(x.dtype)


def causal_depthwise_conv(x, w, b):
    c = x.shape[-1]
    y = lax.conv_general_dilated(
        x, w[:, None, :].astype(x.dtype), window_strides=(1,),
        padding=[(CONV_WIDTH - 1, 0)], dimension_numbers=("NWC", "WIO", "NWC"),
        feature_group_count=c)
    return y + b.astype(x.dtype)


def s5_mixer(u, a_re, a_im, log_dt, b_re, b_im, c_re, c_im, d, w_glu, b_glu, out_g):
    bsz, L, _ = u.shape
    f32 = jnp.float32
    uf = u.astype(f32).reshape(bsz, L, SSM_GROUPS, SSM_GROUP)
    a_re = a_re.astype(f32); a_im = a_im.astype(f32)
    dt = jnp.exp(log_dt.astype(f32))[:, None]
    mag = jnp.exp(a_re * dt)
    ab_re = mag * jnp.cos(a_im * dt)
    ab_im = mag * jnp.sin(a_im * dt)
    den = jnp.square(a_re) + jnp.square(a_im)
    zr = ab_re - 1.0
    s_re = (zr * a_re + ab_im * a_im) / den
    s_im = (ab_im * a_re - zr * a_im) / den
    b_re = b_re.astype(f32); b_im = b_im.astype(f32)
    bb_re = s_re[..., None] * b_re - s_im[..., None] * b_im
    bb_im = s_re[..., None] * b_im + s_im[..., None] * b_re
    bu_re = jnp.einsum('blgp,gnp->blgn', uf, bb_re)
    bu_im = jnp.einsum('blgp,gnp->blgn', uf, bb_im)
    aa_re = jnp.broadcast_to(ab_re, bu_re.shape)
    aa_im = jnp.broadcast_to(ab_im, bu_im.shape)

    def combine(left, right):
        a1r, a1i, b1r, b1i = left
        a2r, a2i, b2r, b2i = right
        ar = a1r * a2r - a1i * a2i
        ai = a1r * a2i + a1i * a2r
        br = a2r * b1r - a2i * b1i + b2r
        bi = a2r * b1i + a2i * b1r + b2i
        return ar, ai, br, bi

    _, _, x_re, x_im = lax.associative_scan(combine, (aa_re, aa_im, bu_re, bu_im), axis=1)
    y = (jnp.einsum('blgn,gpn->blgp', x_re, c_re.astype(f32))
         - jnp.einsum('blgn,gpn->blgp', x_im, c_im.astype(f32))
         + d.astype(f32) * uf)
    y = y.reshape(bsz, L, D_SSM)
    z = jax.nn.gelu(y)
    z = z * jax.nn.sigmoid(z @ w_glu.astype(f32) + b_glu.astype(f32))
    return rmsnorm(z, out_g).astype(u.dtype)


def mlstm_mixer(q_raw, k_raw, v, o_raw, i_raw, f_raw, conv_w, conv_b, b_i, b_f, norm_g):
    bsz, L, _ = v.shape
    nc = L // CHUNK
    f32 = jnp.float32
    qk = jax.nn.silu(causal_depthwise_conv(jnp.concatenate([q_raw, k_raw], -1), conv_w, conv_b))
    q, k = jnp.split(qk, 2, axis=-1)

    def heads(t):
        return t.astype(f32).reshape(bsz, nc, CHUNK, ML_HEADS, ML_HEAD_DIM).transpose(1, 0, 3, 2, 4)

    def gates(t):
        return t.astype(f32).reshape(bsz, nc, CHUNK, ML_HEADS).transpose(1, 0, 3, 2)

    qc = heads(q)
    kc = heads(k) * (1.0 / math.sqrt(ML_HEAD_DIM))
    vc = heads(v)
    ig = gates(i_raw + b_i.astype(i_raw.dtype))
    lf = gates(jax.nn.log_sigmoid((f_raw + b_f.astype(f_raw.dtype)).astype(f32)))
    mask = jnp.tril(jnp.ones((CHUNK, CHUNK), dtype=bool))

    def step(carry, xs):
        c_st, n_st, m_st = carry
        qb, kb, vb, ib, fb = xs
        bcum = jnp.cumsum(fb, axis=-1)
        dmat = bcum[..., :, None] - bcum[..., None, :] + ib[..., None, :]
        dmat = jnp.where(mask, dmat, -jnp.inf)
        inter = bcum + m_st[..., None]
        m_t = jnp.maximum(inter, jnp.max(dmat, axis=-1))
        s = jnp.einsum('bhtd,bhsd->bhts', qb, kb) * jnp.exp(dmat - m_t[..., None])
        sc = jnp.exp(inter - m_t)
        num = (jnp.einsum('bhts,bhsv->bhtv', s, vb)
               + sc[..., None] * jnp.einsum('bhtk,bhkv->bhtv', qb, c_st))
        den = jnp.sum(s, axis=-1) + sc * jnp.einsum('bhtk,bhk->bht', qb, n_st)
        h = num / jnp.maximum(jnp.abs(den), jnp.exp(-m_t))[..., None]
        b_last = bcum[..., -1]
        g = b_last[..., None] - bcum + ib
        m_new = jnp.maximum(b_last + m_st, jnp.max(g, axis=-1))
        decay = jnp.exp(b_last + m_st - m_new)
        wk = jnp.exp(g - m_new[..., None])
        c_new = decay[..., None, None] * c_st + jnp.einsum('bhs,bhsk,bhsv->bhkv', wk, kb, vb)
        n_new = decay[..., None] * n_st + jnp.einsum('bhs,bhsk->bhk', wk, kb)
        return (c_new, n_new, m_new), h

    init = (jnp.zeros((bsz, ML_HEADS, ML_HEAD_DIM, ML_HEAD_DIM), f32),
            jnp.zeros((bsz, ML_HEADS, ML_HEAD_DIM), f32),
            jnp.zeros((bsz, ML_HEADS), f32))
    _, h = lax.scan(step, init, (qc, kc, vc, ig, lf))
    h = h.transpose(1, 0, 3, 2, 4).reshape(bsz, L, ML_HEADS, ML_HEAD_DIM)
    o = jax.nn.sigmoid(o_raw.astype(f32)).reshape(bsz, L, ML_HEADS, ML_HEAD_DIM)
    h = o * h
    h = rmsnorm(h, norm_g.reshape(ML_HEADS, ML_HEAD_DIM))
    return h.reshape(bsz, L, D_MLSTM).astype(v.dtype)


def setup_inputs(seed: int = 0) -> dict:
    key = jax.random.key(seed)
    ks = jax.random.split(key, 26)
    f32 = jnp.float32
    G, N, P, H = SSM_GROUPS, SSM_STATE, SSM_GROUP, ML_HEADS

    def nrm(k, shape, scale):
        return jax.random.normal(k, shape, f32) * scale

    def gain(k, shape):
        return 1.0 + 0.01 * jax.random.normal(k, shape, f32)

    x = jax.random.normal(ks[0], (BATCH, SEQ, D_MODEL), f32)
    norm_mix_g = gain(ks[1], (DEPTH, D_MODEL))
    w_in = nrm(ks[2], (DEPTH, D_MODEL, D_IN), D_MODEL ** -0.5)
    s5_a_re = -0.5 + 0.01 * jax.random.normal(ks[3], (DEPTH, G, N), f32)
    s5_a_im = (math.pi * jnp.arange(N, dtype=f32))[None, None, :] + 0.01 * jax.random.normal(ks[4], (DEPTH, G, N), f32)
    s5_log_dt = jax.random.uniform(ks[5], (DEPTH, G), f32, math.log(DT_MIN), math.log(DT_MAX))
    s5_b_re = nrm(ks[6], (DEPTH, G, N, P), (2 * P) ** -0.5)
    s5_b_im = nrm(ks[7], (DEPTH, G, N, P), (2 * P) ** -0.5)
    s5_c_re = nrm(ks[8], (DEPTH, G, P, N), N ** -0.5)
    s5_c_im = nrm(ks[9], (DEPTH, G, P, N), N ** -0.5)
    s5_d = nrm(ks[10], (DEPTH, G, P), 1.0)
    s5_w_glu = nrm(ks[11], (DEPTH, D_SSM, D_SSM), D_SSM ** -0.5)
    s5_b_glu = nrm(ks[12], (DEPTH, D_SSM), 0.01)
    s5_out_g = gain(ks[13], (DEPTH, D_SSM))
    ml_conv_w = nrm(ks[14], (DEPTH, CONV_WIDTH, 2 * D_MLSTM), CONV_WIDTH ** -0.5)
    ml_conv_b = nrm(ks[15], (DEPTH, 2 * D_MLSTM), 0.01)
    ml_b_i = nrm(ks[16], (DEPTH, H), 0.1)
    ml_b_f = jnp.linspace(3.0, 6.0, H, dtype=f32)[None, :] + 0.01 * jax.random.normal(ks[17], (DEPTH, H), f32)
    ml_norm_g = gain(ks[18], (DEPTH, D_MLSTM))
    w_out = nrm(ks[19], (DEPTH, D_MIX, D_MODEL), D_MIX ** -0.5)
    norm_ffn_g = gain(ks[20], (DEPTH, D_MODEL))
    w_ff1 = nrm(ks[21], (DEPTH, D_MODEL, D_FF), D_MODEL ** -0.5)
    w_ff2 = nrm(ks[22], (DEPTH, D_FF, D_MODEL), D_FF ** -0.5)
    final_norm_g = gain(ks[23], (D_MODEL,))
    return {"x": x, "norm_mix_g": norm_mix_g, "w_in": w_in,
            "s5_a_re": s5_a_re, "s5_a_im": s5_a_im, "s5_log_dt": s5_log_dt,
            "s5_b_re": s5_b_re, "s5_b_im": s5_b_im, "s5_c_re": s5_c_re, "s5_c_im": s5_c_im,
            "s5_d": s5_d, "s5_w_glu": s5_w_glu, "s5_b_glu": s5_b_glu, "s5_out_g": s5_out_g,
            "ml_conv_w": ml_conv_w, "ml_conv_b": ml_conv_b, "ml_b_i": ml_b_i, "ml_b_f": ml_b_f,
            "ml_norm_g": ml_norm_g, "w_out": w_out, "norm_ffn_g": norm_ffn_g,
            "w_ff1": w_ff1, "w_ff2": w_ff2, "final_norm_g": final_norm_g}


def reference(x, norm_mix_g, w_in, s5_a_re, s5_a_im, s5_log_dt, s5_b_re, s5_b_im,
              s5_c_re, s5_c_im, s5_d, s5_w_glu, s5_b_glu, s5_out_g, ml_conv_w, ml_conv_b,
              ml_b_i, ml_b_f, ml_norm_g, w_out, norm_ffn_g, w_ff1, w_ff2, final_norm_g):
    sizes = [D_SSM, D_MLSTM, D_MLSTM, D_MLSTM, D_MLSTM, ML_HEADS, ML_HEADS]
    cuts = [int(c) for c in np.cumsum(sizes)[:-1]]
    for l in range(DEPTH):
        h = rmsnorm(x, norm_mix_g[l])
        p = h @ w_in[l]
        u, q_raw, k_raw, v, o_raw, i_raw, f_raw = jnp.split(p, cuts, axis=-1)
        y_ssm = s5_mixer(u, s5_a_re[l], s5_a_im[l], s5_log_dt[l], s5_b_re[l], s5_b_im[l],
                         s5_c_re[l], s5_c_im[l], s5_d[l], s5_w_glu[l], s5_b_glu[l], s5_out_g[l])
        y_ml = mlstm_mixer(q_raw, k_raw, v, o_raw, i_raw, f_raw, ml_conv_w[l], ml_conv_b[l],
                           ml_b_i[l], ml_b_f[l], ml_norm_g[l])
        x = x + jnp.concatenate([y_ssm, y_ml], axis=-1) @ w_out[l]
        h = rmsnorm(x, norm_ffn_g[l])
        x = x + jnp.square(jax.nn.relu(h @ w_ff1[l])) @ w_ff2[l]
    return rmsnorm(x, final_norm_g)
```

```cpp
#include <hip/hip_runtime.h>
#include <cstdio>
#include <cstdint>
namespace pg8 {
#define PG8_LAS __attribute__((address_space(3)))
typedef unsigned short bf16_t;
typedef short bf16x8 __attribute__((ext_vector_type(8)));
typedef float f32x4 __attribute__((ext_vector_type(4)));
typedef unsigned u32x4 __attribute__((ext_vector_type(4)));
constexpr int BM = 256, BK = 64, HALF = 128, HTB = HALF * BK * 2  , STAGE_BYTES = 8 * HTB, NXCD = 8, WGM = 8;

__host__ __device__ __forceinline__ int lds_byte(int r, int c) { const int st = (r >> 4) * 2 + (c >> 5), rr = r & 15, cc = c & 31, ob = rr * 64 + cc * 2; return st * 1024 + (ob ^ (((ob >> 9) & 1) << 5)); }
__host__ __device__ __forceinline__ void stage_rc(int b, int& R, int& C) { const int st = b / 1024, sb = b % 1024, swz = sb ^ (((sb >> 9) & 1) << 5); R = (st >> 1) * 16 + swz / 64; C = (st & 1) * 32 + (swz % 64) / 2; }
__host__ __device__ __forceinline__ int perm32(int rho) { const int n = rho >> 4, i = rho & 15; return 8 * (i >> 2) + 4 * n + (i & 3); }

struct Unit { int pm, pn; };
struct Gemm { const bf16_t* A; const bf16_t* Bt; int M, N, K; };

struct StaticOrder {
    int nM, nN, nwg, G, c;
    __host__ __device__ void init(int M, int N, int G_, int c_) { nM = M / BM; nN = N / BM; nwg = nM * nN; G = G_; c = c_; }
    __host__ __device__ bool next(int i, Unit& u) const {
        const long L = (long)i * G + c; if (L >= nwg) return false;
        int wgid = (int)L; { const int q = nwg / NXCD, r = nwg % NXCD, xcd = wgid % NXCD, off = wgid / NXCD; wgid = (xcd < r ? xcd * (q + 1) : r * (q + 1) + (xcd - r) * q) + off; }
        const int nig = WGM * nN, gid = wgid / nig, fm = gid * WGM, gsz = (nM - fm) < WGM ? (nM - fm) : WGM;
        u.pm = fm + ((wgid % nig) % gsz); u.pn = (wgid % nig) / gsz; return true;
    }
    __device__ __forceinline__ void a_ready(const Unit&) const {}
    __device__ __forceinline__ void done(const Unit&) const {}
};
__device__ __forceinline__ unsigned cvt_pk_bf16(float lo, float hi) { unsigned r; asm volatile("v_cvt_pk_bf16_f32 %0, %1, %2" : "=v"(r) : "v"(lo), "v"(hi)); return r; }

template <class Epi, class Sched, bool ALIGN_EPI = false, bool SP2 = false>
__device__ __forceinline__ void gemm_phase(PG8_LAS unsigned char* lds, const Gemm g, const Sched& S, const Epi& E, const int tid) {
    const int wid = __builtin_amdgcn_readfirstlane(tid >> 6), lane = tid & 63, wr = wid >> 2, wc = wid & 3, fr = lane & 15, fq = lane >> 4;
    const int K = g.K, nt = K / BK;
    unsigned voffA[2], voffB[2];
#pragma unroll
    for (int i = 0; i < 2; ++i) { int R, C; stage_rc(tid * 16 + i * 8192, R, C); const int Rb = E.perm() ? ((R & ~31) + perm32(R & 31)) : R;
        voffA[i] = (unsigned)(R * K + C) * 2u; voffB[i] = (unsigned)(Rb * K + C) * 2u; }
    const size_t kstep = (size_t)(BK * 2);
    const size_t hstep = (size_t)HALF * K * 2;
    const size_t tstep = 2 * hstep;
    const unsigned ldsw = (unsigned)wid * 1024u;
    const int aoff = lds_byte(wr * 64 + fr, fq * 8), boff = lds_byte(wc * 32 + fr, fq * 8);
#define PG8_SA(b, h) (((b) * 2 + (h)) * HTB)
#define PG8_SB(b, h) ((4 + (b) * 2 + (h)) * HTB)
#define PG8_STAGE(bufoff, gbase, voff) do { _Pragma("unroll") for (int _i = 0; _i < 2; ++_i) \
        __builtin_amdgcn_global_load_lds((const unsigned*)((const char*)(gbase) + (voff)[_i]), (PG8_LAS unsigned*)(lds + (bufoff) + ldsw + _i * 8192), 16, 0, 0); } while (0)
#define PG8_LDA(dst, b, h) do { _Pragma("unroll") for (int m = 0; m < 4; ++m) _Pragma("unroll") for (int k = 0; k < 2; ++k) dst[m][k] = *(const PG8_LAS bf16x8*)(lds + PG8_SA(b, h) + aoff + m * 2048 + k * 1024); } while (0)
#define PG8_LDB(dst, b, h) do { _Pragma("unroll") for (int n = 0; n < 2; ++n) _Pragma("unroll") for (int k = 0; k < 2; ++k) dst[n][k] = *(const PG8_LAS bf16x8*)(lds + PG8_SB(b, h) + boff + n * 2048 + k * 1024); } while (0)
#define PG8_MMA(ai, bj, At, Bt) do { __builtin_amdgcn_s_setprio(1); _Pragma("unroll") for (int m = 0; m < 4; ++m) _Pragma("unroll") for (int n = 0; n < 2; ++n) _Pragma("unroll") for (int k = 0; k < 2; ++k) \
        acc[ai][bj][m][n] = __builtin_amdgcn_mfma_f32_16x16x32_bf16(Bt[n][k], At[m][k], acc[ai][bj][m][n], 0, 0, 0); __builtin_amdgcn_s_setprio(0); } while (0)
#define PG8_WAIT_V(n) asm volatile("s_waitcnt vmcnt(" #n ")" ::: "memory")
#define PG8_WAIT_L(n) asm volatile("s_waitcnt lgkmcnt(" #n ")" ::: "memory")
#define PG8_BAR __builtin_amdgcn_s_barrier()
#define PG8_SCHED __builtin_amdgcn_sched_barrier(0)
    Unit cur, nxt; int ui = 0;
    if (!S.next(0, cur)) return;
    f32x4 acc[2][2][4][2];
#pragma unroll
    for (int a = 0; a < 2; ++a)
#pragma unroll
        for (int b = 0; b < 2; ++b)
#pragma unroll
            for (int m = 0; m < 4; ++m)
#pragma unroll
                for (int n = 0; n < 2; ++n) acc[a][b][m][n] = (f32x4){0.f, 0.f, 0.f, 0.f};
    bf16x8 At[4][2], B0[2][2], B1[2][2];
    const char* cA = (const char*)g.A + (size_t)cur.pm * tstep; const char* cB = (const char*)g.Bt + (size_t)cur.pn * tstep;
    S.a_ready(cur);
    if constexpr (SP2) {
        PG8_STAGE(PG8_SB(0, 0), cB, voffB); PG8_STAGE(PG8_SB(0, 1), cB + hstep, voffB); PG8_STAGE(PG8_SA(0, 0), cA, voffA); PG8_STAGE(PG8_SA(0, 1), cA + hstep, voffA);
        if (wr == 1) PG8_BAR;
        PG8_WAIT_V(2); PG8_BAR;
        PG8_STAGE(PG8_SB(1, 0), cB + kstep, voffB); PG8_STAGE(PG8_SA(1, 0), cA + kstep, voffA); PG8_STAGE(PG8_SB(1, 1), cB + hstep + kstep, voffB);
        PG8_WAIT_V(6); PG8_BAR;
    } else {
        PG8_STAGE(PG8_SB(0, 0), cB, voffB); PG8_STAGE(PG8_SA(0, 0), cA, voffA); PG8_STAGE(PG8_SB(0, 1), cB + hstep, voffB); PG8_STAGE(PG8_SA(0, 1), cA + hstep, voffA);
        if (wr == 1) PG8_BAR;
        PG8_WAIT_V(4); PG8_BAR;
        PG8_STAGE(PG8_SB(1, 0), cB + kstep, voffB); PG8_STAGE(PG8_SA(1, 0), cA + kstep, voffA); PG8_STAGE(PG8_SB(1, 1), cB + hstep + kstep, voffB);
        PG8_WAIT_V(6); PG8_BAR;
    }
    for (;;) {
        const bool has_next = S.next(ui + 1, nxt);
        const char* nA = has_next ? (const char*)g.A + (size_t)nxt.pm * tstep : cA; const char* nB = has_next ? (const char*)g.Bt + (size_t)nxt.pn * tstep : cB;
        for (int t = 0; t < nt; t += 2) {
            const bool last = (t == nt - 2);
            const char* a1 = cA + (size_t)(t + 1) * kstep;
            const char* a2 = last ? nA : cA + (size_t)(t + 2) * kstep; const char* b2 = last ? nB : cB + (size_t)(t + 2) * kstep;
            const char* a3 = a2 + kstep; const char* b3 = b2 + kstep;
            if (last && has_next) S.a_ready(nxt);
            if (t == E.mid_t()) E.mid(acc, cur, wr, wc, fr, fq);
            if constexpr (SP2) {
            PG8_LDB(B0, 0, 0); PG8_LDB(B1, 0, 1); PG8_SCHED; PG8_LDA(At, 0, 0); PG8_STAGE(PG8_SA(1, 1), a1 + hstep, voffA);
            PG8_WAIT_V(8); PG8_WAIT_L(0); PG8_BAR; PG8_MMA(0, 0, At, B0); PG8_MMA(0, 1, At, B1); PG8_BAR; PG8_SCHED;
            PG8_LDA(At, 0, 1); PG8_STAGE(PG8_SB(0, 0), b2, voffB); PG8_STAGE(PG8_SB(0, 1), b2 + hstep, voffB); PG8_STAGE(PG8_SA(0, 0), a2, voffA);
            PG8_WAIT_V(8); PG8_WAIT_L(0); PG8_BAR; PG8_MMA(1, 0, At, B0); PG8_MMA(1, 1, At, B1); PG8_BAR; PG8_SCHED;
            PG8_LDB(B0, 1, 0); PG8_LDB(B1, 1, 1); PG8_SCHED; PG8_LDA(At, 1, 0); PG8_STAGE(PG8_SA(0, 1), a2 + hstep, voffA);
            PG8_WAIT_V(8); PG8_WAIT_L(0); PG8_BAR; PG8_MMA(0, 0, At, B0); PG8_MMA(0, 1, At, B1); PG8_BAR; PG8_SCHED;
            PG8_LDA(At, 1, 1); PG8_STAGE(PG8_SB(1, 0), b3, voffB); PG8_STAGE(PG8_SB(1, 1), b3 + hstep, voffB); PG8_STAGE(PG8_SA(1, 0), a3, voffA);
            PG8_WAIT_V(8); PG8_WAIT_L(0); PG8_BAR; PG8_MMA(1, 0, At, B0); PG8_MMA(1, 1, At, B1); PG8_BAR; PG8_SCHED;
            } else {
            PG8_LDB(B0, 0, 0); PG8_SCHED; PG8_LDA(At, 0, 0); PG8_STAGE(PG8_SA(1, 1), a1 + hstep, voffA);
            PG8_WAIT_L(8); PG8_BAR; PG8_WAIT_L(0); PG8_MMA(0, 0, At, B0); PG8_BAR; PG8_SCHED;
            PG8_LDB(B1, 0, 1); PG8_STAGE(PG8_SB(0, 0), b2, voffB);
            PG8_BAR; PG8_WAIT_L(0); PG8_MMA(0, 1, At, B1); PG8_BAR;
            PG8_LDA(At, 0, 1); PG8_STAGE(PG8_SA(0, 0), a2, voffA);
            PG8_BAR; PG8_WAIT_L(0); PG8_MMA(1, 0, At, B0); PG8_BAR; PG8_SCHED;
            PG8_STAGE(PG8_SB(0, 1), b2 + hstep, voffB);
            PG8_WAIT_V(6); PG8_BAR; PG8_MMA(1, 1, At, B1); PG8_BAR;
            PG8_LDB(B0, 1, 0); PG8_SCHED; PG8_LDA(At, 1, 0); PG8_STAGE(PG8_SA(0, 1), a2 + hstep, voffA);
            PG8_WAIT_L(8); PG8_BAR; PG8_WAIT_L(0); PG8_MMA(0, 0, At, B0); PG8_BAR; PG8_SCHED;
            PG8_LDB(B1, 1, 1); PG8_STAGE(PG8_SB(1, 0), b3, voffB);
            PG8_BAR; PG8_WAIT_L(0); PG8_MMA(0, 1, At, B1); PG8_BAR;
            PG8_LDA(At, 1, 1); PG8_STAGE(PG8_SA(1, 0), a3, voffA);
            PG8_BAR; PG8_WAIT_L(0); PG8_MMA(1, 0, At, B0); PG8_BAR; PG8_SCHED;
            PG8_STAGE(PG8_SB(1, 1), b3 + hstep, voffB);
            PG8_WAIT_V(6); PG8_BAR; PG8_MMA(1, 1, At, B1); PG8_BAR;
            }
        }
        if constexpr (ALIGN_EPI) { if (wr == 0) PG8_BAR; }
        if constexpr (!Epi::AFTER_DRAIN) { E(acc, cur, wr, wc, fr, fq); S.done(cur); }
        if (!has_next) break;
#pragma unroll
        for (int a = 0; a < 2; ++a)
#pragma unroll
            for (int b = 0; b < 2; ++b)
#pragma unroll
                for (int m = 0; m < 4; ++m)
#pragma unroll
                    for (int n = 0; n < 2; ++n) acc[a][b][m][n] = (f32x4){0.f, 0.f, 0.f, 0.f};
        cur = nxt; cA = nA; cB = nB; ++ui;
        if constexpr (ALIGN_EPI) { if (wr == 1) PG8_BAR; }
    }
    PG8_WAIT_V(0);
    if constexpr (!ALIGN_EPI) { if (wr == 0) PG8_BAR; }
    PG8_BAR;
    if constexpr (Epi::AFTER_DRAIN) { E.fused(acc, cur, wr, wc, fr, fq, lds, wid, lane); S.done(cur); }
#undef PG8_SA
#undef PG8_SB
#undef PG8_STAGE
#undef PG8_LDA
#undef PG8_LDB
#undef PG8_MMA
#undef PG8_WAIT_V
#undef PG8_WAIT_L
#undef PG8_BAR
#undef PG8_SCHED
}
}

#define GAS __attribute__((address_space(1)))
#define LAS __attribute__((address_space(3)))
typedef unsigned short bf16_t;
typedef short bf16x8 __attribute__((ext_vector_type(8)));
typedef float f32x4 __attribute__((ext_vector_type(4)));
typedef float f32x16 __attribute__((ext_vector_type(16)));
typedef unsigned u32x4 __attribute__((ext_vector_type(4)));
typedef unsigned u32x2 __attribute__((ext_vector_type(2)));
constexpr int NWAVES = 8, NTHR = 512;
constexpr int M = 16384, D = 1024, NP = 2560, DIN = 2568, DS = 512, NG = 32, NS = 64, NH = 4, DH = 128, DFF = 4096, NCHUNK = 256, CPB = 128, NITEM = 1024;
constexpr float EPS = 1e-6f;
constexpr size_t MiB = 1u << 20, KiB = 1024;
constexpr size_t WS_CTL = 0, CTL_ZERO_BYTES = 64 * KiB;
constexpr size_t WS_W = 1 * MiB, W_LSTRIDE = 24 * MiB;
constexpr size_t OFF_WIN = 0, OFF_WG = 5 * MiB, OFF_WGLU = 5 * MiB + 64 * KiB, OFF_WOUT = 6 * MiB, OFF_W1 = 8 * MiB, OFF_W2 = 16 * MiB;
constexpr size_t KTAB_G = 65 * 256;
constexpr size_t WS_KTAB = 49 * MiB, WS_A64 = 50 * MiB + 256 * KiB, WS_WST = 51 * MiB, WS_GT = 59 * MiB;
constexpr size_t WS_SLOTS = 67 * MiB, WS_SLOTS2 = 68 * MiB, WS_BCUM = 68 * MiB + 512 * KiB, WS_AARR = WS_BCUM + 256 * KiB, WS_PMAX = WS_AARR + 256 * KiB;
constexpr size_t WS_BLAST = WS_PMAX + 256 * KiB, WS_MAXG = WS_BLAST + 4 * KiB, WS_MST = WS_MAXG + 4 * KiB;
constexpr size_t WS_NLOC = 69 * MiB + 512 * KiB, WS_XLOC = 70 * MiB, WS_XPREV = 74 * MiB;
constexpr size_t WS_U2 = 76 * MiB, WS_QRAW = 92 * MiB, WS_Z = WS_QRAW, WS_KRAW = 108 * MiB, WS_VT = 124 * MiB, WS_ORAW = 140 * MiB, WS_QC = 156 * MiB, WS_KC = 172 * MiB;
constexpr size_t WS_DC = 188 * MiB, WS_YCAT = WS_DC, WS_XB = 220 * MiB, WS_CST = WS_XB, WS_H1 = 76 * MiB, WS_END = 253 * MiB;
constexpr size_t CSTR = 129 * 128;
static_assert(WS_CST + (size_t)NITEM * CSTR * 2 + 32 * 256 <= WS_END && WS_H1 + (size_t)M * DFF * 2 <= WS_XB && WS_BLAST + 12 * KiB <= WS_NLOC, "ws map");
constexpr int CW_BAR = 4096;
constexpr int RING_BYTES = 131072, LDS_BYTES = 160 * 1024, MISC_OFF = LDS_BYTES - 256;

#define RLX_AGENT __ATOMIC_RELAXED, __HIP_MEMORY_SCOPE_AGENT
#define LDS_WAIT() asm volatile("s_waitcnt lgkmcnt(0)" ::: "memory")
#define VM_WAIT() asm volatile("s_waitcnt vmcnt(0)" ::: "memory")
#define MFMA32(a, b, c) __builtin_amdgcn_mfma_f32_32x32x16_bf16((a), (b), (c), 0, 0, 0)
__device__ __forceinline__ float bf2f(unsigned b) { return __uint_as_float(b << 16); }
__device__ __forceinline__ unsigned f2bf(float f) { unsigned u = __float_as_uint(f); return (u + 0x7fffu + ((u >> 16) & 1u)) >> 16; }
__device__ __forceinline__ unsigned pk2(float lo, float hi) { return f2bf(lo) | (f2bf(hi) << 16); }
__device__ __forceinline__ float wave_sum(float v) {
#pragma unroll
    for (int o = 1; o < 64; o <<= 1) v += __shfl_xor(v, o);
    return v;
}
__device__ __forceinline__ float sigmoid_f(float x) { return 1.0f / (1.0f + __expf(-x)); }
__device__ __forceinline__ float logsigmoid_f(float x) { return fminf(x, 0.f) - log1pf(__expf(-fabsf(x))); }
__device__ __forceinline__ float gelu_tanh(float x) { const float u = 0.7978845608028654f * (x + 0.044715f * x * x * x); const float e = __expf(2.0f * u); const float th = 1.0f - 2.0f / (e + 1.0f); return 0.5f * x * (1.0f + th); }
__device__ __forceinline__ int crow(int reg, int hh) { return (reg & 3) + 8 * (reg >> 2) + 4 * hh; }
__device__ __forceinline__ float sum16(const float* p) { const f32x4 a = ((const f32x4*)p)[0], b = ((const f32x4*)p)[1], c = ((const f32x4*)p)[2], d = ((const f32x4*)p)[3];
    return ((a.x + a.y) + (a.z + a.w)) + ((b.x + b.y) + (b.z + b.w)) + ((c.x + c.y) + (c.z + c.w)) + ((d.x + d.y) + (d.z + d.w)); }
__device__ __forceinline__ float sum8(const float* p) { const f32x4 a = ((const f32x4*)p)[0], b = ((const f32x4*)p)[1]; return ((a.x + a.y) + (a.z + a.w)) + ((b.x + b.y) + (b.z + b.w)); }

#define XB_TMO      128
#define XB_XCNT(j)  (256  + 64 * (j))
#define XB_XSUB(j)  (1280 + 64 * (j))
#define XB_XGEN(j)  (2304 + 64 * (j))
#define XB_TOP      3328
#define XB_TOPGEN   3392
#define XCD_BAR_WORDS 3456
#define XB_SPIN_CAP (1u << 20)
__device__ __forceinline__ unsigned xb_ld(unsigned* p)              { return __hip_atomic_load(p, __ATOMIC_RELAXED, __HIP_MEMORY_SCOPE_AGENT); }
__device__ __forceinline__ unsigned xb_add(unsigned* p, unsigned v) { return __hip_atomic_fetch_add(p, v, __ATOMIC_RELAXED, __HIP_MEMORY_SCOPE_AGENT); }
__device__ __forceinline__ unsigned xb_xcc_id() { return (unsigned)__builtin_amdgcn_s_getreg((3 << 11) | 20) & 0xFu; }
#define XB_SPIN(cond, bar) do { unsigned _sp = 0; while (cond) { __builtin_amdgcn_s_sleep(1); \
    if ((++_sp & 255u) == 0u) { if (xb_ld(&(bar)[XB_TMO])) break; if (_sp > XB_SPIN_CAP) { atomicAdd(&(bar)[XB_TMO], 1u); break; } } } } while (0)
struct XcdBarrier { unsigned* bar; unsigned x; volatile LAS unsigned* st; };
__device__ __forceinline__ XcdBarrier xcd_barrier_post(unsigned* bar, volatile LAS unsigned* st) {
    XcdBarrier b; b.bar = bar; b.x = xb_xcc_id(); b.st = st;
    if (threadIdx.x == 0) (void)xb_add(&bar[XB_XCNT(b.x)], 1u);
    return b;
}
__device__ __forceinline__ void xcd_barrier_complete(unsigned* bar, unsigned x, unsigned& nloc, unsigned& nx) {
    const unsigned G = gridDim.x * gridDim.y * gridDim.z;
    unsigned sum, cnt, mine, sp = 0u;
    for (;;) {
        sum = 0u; cnt = 0u; mine = 0u;
#pragma unroll 1
        for (unsigned j = 0; j < 16; ++j) { const unsigned c = xb_ld(&bar[XB_XCNT(j)]); sum += c; cnt += (c > 0u) ? 1u : 0u; mine = (j == x) ? c : mine; }
        if (sum == G) break;
        __builtin_amdgcn_s_sleep(1);
        if ((++sp & 255u) == 0u) { if (xb_ld(&bar[XB_TMO])) break; if (sp > XB_SPIN_CAP) { atomicAdd(&bar[XB_TMO], 1u); break; } }
    }
    nloc = mine > 0u ? mine : 1u; nx = cnt > 0u ? cnt : 1u;
}
__device__ __forceinline__ void xcd_barrier(const XcdBarrier& b, unsigned* bar_in, bool leader) {
    asm volatile("s_waitcnt vmcnt(0)" ::: "memory");
    __syncthreads();
    if (leader) {
        unsigned* bar = bar_in;
        __builtin_amdgcn_s_waitcnt(0);
        unsigned nloc = b.st[0], nx = b.st[1];
        if (nloc == 0u) { xcd_barrier_complete(bar, b.x, nloc, nx); b.st[0] = nloc; b.st[1] = nx; }
        const unsigned old = xb_add(&bar[XB_XSUB(b.x)], 1u);
        const unsigned gen = old / nloc;
        if (old + 1u == (gen + 1u) * nloc) {
            __builtin_amdgcn_fence(__ATOMIC_RELEASE, "agent");
            asm volatile("s_waitcnt vmcnt(0)" ::: "memory");
            const unsigned og = xb_add(&bar[XB_TOP], 1u);
            const unsigned tg = og / nx;
            if (og + 1u == (tg + 1u) * nx) xb_add(&bar[XB_TOPGEN], 1u);
            else XB_SPIN(xb_ld(&bar[XB_TOPGEN]) == tg, bar);
            __builtin_amdgcn_fence(__ATOMIC_ACQUIRE, "agent");
            xb_add(&bar[XB_XGEN(b.x)], 1u);
            asm volatile("s_waitcnt vmcnt(0)" ::: "memory");
        } else {
            XB_SPIN(xb_ld(&bar[XB_XGEN(b.x)]) == gen, bar);
            __builtin_amdgcn_fence(__ATOMIC_ACQUIRE, "agent");
            asm volatile("s_waitcnt vmcnt(0)" ::: "memory");
        }
    }
    __syncthreads();
}

using pg8::Unit; using pg8::cvt_pk_bf16;
__device__ __forceinline__ float sum_fq(float v) {
    { auto r = __builtin_amdgcn_permlane16_swap(__float_as_uint(v), __float_as_uint(v), false, false); v = __uint_as_float(r[0]) + __uint_as_float(r[1]); }
    { auto r = __builtin_amdgcn_permlane32_swap(__float_as_uint(v), __float_as_uint(v), false, false); v = __uint_as_float(r[0]) + __uint_as_float(r[1]); }
    return v;
}
typedef const f32x4 (&AccC)[2][2][4][2];
typedef f32x4 (&AccM)[2][2][4][2];
__device__ __forceinline__ float sum16o(const unsigned char* base, unsigned off) { const f32x4 a = *(const f32x4*)(base + off), b = *(const f32x4*)(base + off + 16u), c = *(const f32x4*)(base + off + 32u), d = *(const f32x4*)(base + off + 48u);
    return ((a.x + a.y) + (a.z + a.w)) + ((b.x + b.y) + (b.z + b.w)) + ((c.x + c.y) + (c.z + c.w)) + ((d.x + d.y) + (d.z + d.w)); }
__device__ __forceinline__ float sum8o(const unsigned char* base, unsigned off) { const f32x4 a = *(const f32x4*)(base + off), b = *(const f32x4*)(base + off + 16u); return ((a.x + a.y) + (a.z + a.w)) + ((b.x + b.y) + (b.z + b.w)); }
__device__ __forceinline__ void epi_g1(AccC acc, const Unit& u, int wr, int wc, int fr, int fq, unsigned char* ws) {
    const unsigned row0 = (unsigned)(u.pm * 256 + wr * 64 + fr), colt = (unsigned)(u.pn * 256);
#pragma unroll
    for (int ai = 0; ai < 2; ++ai)
#pragma unroll
        for (int m = 0; m < 4; ++m) {
            const unsigned row = row0 + ai * 128 + m * 16;
            const float rs = rsqrtf(sum16o(ws, (unsigned)WS_SLOTS + row * 64u) * (1.0f / D) + EPS);
#pragma unroll
            for (int bj = 0; bj < 2; ++bj) {
                const unsigned c0 = colt + bj * 128 + wc * 32 + 8 * fq;
                const f32x4 v0 = acc[ai][bj][m][0] * rs, v1 = acc[ai][bj][m][1] * rs;
                u32x4 w; w.x = cvt_pk_bf16(v0[0], v0[1]); w.y = cvt_pk_bf16(v0[2], v0[3]); w.z = cvt_pk_bf16(v1[0], v1[1]); w.w = cvt_pk_bf16(v1[2], v1[3]);
                if (u.pn < 2) { const unsigned g = c0 >> 4, p0 = c0 & 15u; *(u32x4*)(ws + ((unsigned)WS_U2 + (g * (unsigned)M + row) * 32u + p0 * 2u)) = w; }
                else if (u.pn == 6 || u.pn == 7) {
                    const unsigned cv = c0 - 1536u, hh = cv >> 7, dv = cv & 127u, cid = row >> 6, s = row & 63u;
                    bf16_t* b = (bf16_t*)(ws + ((unsigned)WS_VT + (((cid * 4u + hh) * 128u + dv) * 64u + s) * 2u));
                    b[0] = (bf16_t)(w.x & 0xffffu); b[64] = (bf16_t)(w.x >> 16); b[128] = (bf16_t)(w.y & 0xffffu); b[192] = (bf16_t)(w.y >> 16);
                    b[256] = (bf16_t)(w.z & 0xffffu); b[320] = (bf16_t)(w.z >> 16); b[384] = (bf16_t)(w.w & 0xffffu); b[448] = (bf16_t)(w.w >> 16);
                } else {
                    const unsigned toff = u.pn < 4 ? (unsigned)WS_QRAW : (u.pn < 6 ? (unsigned)WS_KRAW : (unsigned)WS_ORAW), cb = c0 - (u.pn < 4 ? 512u : (u.pn < 6 ? 1024u : 2048u));
                    *(u32x4*)(ws + (toff + (row * 512u + cb) * 2u)) = w;
                }
            }
            asm volatile("" ::: "memory");
        }
}
__device__ __forceinline__ void epi_g2(AccC acc, const Unit& u, int wr, int wc, int fr, int fq, unsigned char* ws, const float* bglu) {
    const unsigned row0 = (unsigned)(u.pm * 256 + wr * 64 + fr), colt = (unsigned)(u.pn * 256);
#pragma unroll
    for (int ai = 0; ai < 2; ++ai)
#pragma unroll
        for (int m = 0; m < 4; ++m) {
            const unsigned row = row0 + ai * 128 + m * 16; float ss = 0.f;
#pragma unroll
            for (int bj = 0; bj < 2; ++bj) {
                const unsigned c0 = colt + bj * 128 + wc * 32 + 8 * fq;
                const u32x4 zv = *(const u32x4*)(ws + ((unsigned)WS_Z + (row * 512u + c0) * 2u));
                const f32x4 b0 = *(const f32x4*)((const unsigned char*)bglu + c0 * 4u), b1 = *(const f32x4*)((const unsigned char*)bglu + c0 * 4u + 16u);
                const f32x4 a0 = acc[ai][bj][m][0] + b0, a1 = acc[ai][bj][m][1] + b1;
                float zz[8];
                zz[0] = bf2f(zv.x & 0xffffu) * sigmoid_f(a0[0]); zz[1] = bf2f(zv.x >> 16) * sigmoid_f(a0[1]);
                zz[2] = bf2f(zv.y & 0xffffu) * sigmoid_f(a0[2]); zz[3] = bf2f(zv.y >> 16) * sigmoid_f(a0[3]);
                zz[4] = bf2f(zv.z & 0xffffu) * sigmoid_f(a1[0]); zz[5] = bf2f(zv.z >> 16) * sigmoid_f(a1[1]);
                zz[6] = bf2f(zv.w & 0xffffu) * sigmoid_f(a1[2]); zz[7] = bf2f(zv.w >> 16) * sigmoid_f(a1[3]);
#pragma unroll
                for (int j = 0; j < 8; ++j) ss += zz[j] * zz[j];
                u32x4 w; w.x = cvt_pk_bf16(zz[0], zz[1]); w.y = cvt_pk_bf16(zz[2], zz[3]); w.z = cvt_pk_bf16(zz[4], zz[5]); w.w = cvt_pk_bf16(zz[6], zz[7]);
                *(u32x4*)(ws + ((unsigned)WS_YCAT + (row * 1024u + c0) * 2u)) = w;
            }
            ss = sum_fq(ss);
            if (fq == 0) *(float*)(ws + ((unsigned)WS_SLOTS2 + (row * 8u + (unsigned)(u.pn * 4 + wc)) * 4u)) = ss;
            asm volatile("" ::: "memory");
        }
}
__device__ __forceinline__ void mid_g3(AccM acc, const Unit& u, int wr, int fr, unsigned char* ws) {
    const unsigned row0 = (unsigned)(u.pm * 256 + wr * 64 + fr);
#pragma unroll
    for (int ai = 0; ai < 2; ++ai)
#pragma unroll
        for (int m = 0; m < 4; ++m) {
            const unsigned row = row0 + ai * 128 + m * 16;
            const float r = rsqrtf(sum8o(ws, (unsigned)WS_SLOTS2 + row * 32u) * (1.0f / DS) + EPS);
#pragma unroll
            for (int bj = 0; bj < 2; ++bj)
#pragma unroll
                for (int n = 0; n < 2; ++n) acc[ai][bj][m][n] = acc[ai][bj][m][n] * r;
            asm volatile("" ::: "memory");
        }
}
__device__ __forceinline__ void epi_res(AccC acc, const Unit& u, int wr, int wc, int fr, int fq, unsigned char* ws, const float* xold, float* X) {
    const unsigned row0 = (unsigned)(u.pm * 256 + wr * 64 + fr), colt = (unsigned)(u.pn * 256);
#pragma unroll
    for (int ai = 0; ai < 2; ++ai)
#pragma unroll
        for (int m = 0; m < 4; ++m) {
            const unsigned row = row0 + ai * 128 + m * 16; float ss = 0.f;
            const unsigned off = row * 1024u + colt + wc * 32 + 4 * fq;
#pragma unroll
            for (int bj = 0; bj < 2; ++bj)
#pragma unroll
                for (int n = 0; n < 2; ++n) {
                    const unsigned o = off + bj * 128 + n * 16;
                    const f32x4 xn = *(const f32x4*)((const unsigned char*)xold + o * 4u) + acc[ai][bj][m][n];
                    *(f32x4*)((unsigned char*)X + o * 4u) = xn;
                    u32x2 w; w.x = cvt_pk_bf16(xn[0], xn[1]); w.y = cvt_pk_bf16(xn[2], xn[3]);
                    *(u32x2*)(ws + ((unsigned)WS_XB + o * 2u)) = w;
                    ss += (xn[0] * xn[0] + xn[1] * xn[1]) + (xn[2] * xn[2] + xn[3] * xn[3]);
                }
            ss = sum_fq(ss);
            if (fq == 0) *(float*)(ws + ((unsigned)WS_SLOTS + (row * 16u + (unsigned)(u.pn * 4 + wc)) * 4u)) = ss;
            asm volatile("" ::: "memory");
        }
}
__device__ __forceinline__ void epi_g4(AccC acc, const Unit& u, int wr, int wc, int fr, int fq, unsigned char* ws) {
    const unsigned row0 = (unsigned)(u.pm * 256 + wr * 64 + fr), colt = (unsigned)(u.pn * 256);
#pragma unroll
    for (int ai = 0; ai < 2; ++ai)
#pragma unroll
        for (int m = 0; m < 4; ++m) {
            const unsigned row = row0 + ai * 128 + m * 16;
            const float r2 = 1.0f / (sum16o(ws, (unsigned)WS_SLOTS + row * 64u) * (1.0f / D) + EPS);
#pragma unroll
            for (int bj = 0; bj < 2; ++bj) {
                const unsigned c0 = colt + bj * 128 + wc * 32 + 8 * fq;
                f32x4 v0 = acc[ai][bj][m][0], v1 = acc[ai][bj][m][1];
#pragma unroll
                for (int j = 0; j < 4; ++j) { const float a = fmaxf(v0[j], 0.f), b = fmaxf(v1[j], 0.f); v0[j] = a * a * r2; v1[j] = b * b * r2; }
                u32x4 w; w.x = cvt_pk_bf16(v0[0], v0[1]); w.y = cvt_pk_bf16(v0[2], v0[3]); w.z = cvt_pk_bf16(v1[0], v1[1]); w.w = cvt_pk_bf16(v1[2], v1[3]);
                *(u32x4*)(ws + ((unsigned)WS_H1 + (row * (unsigned)DFF + c0) * 2u)) = w;
            }
            asm volatile("" ::: "memory");
        }
}
template <int KIND> struct EpiK {
    static constexpr bool AFTER_DRAIN = false;
    unsigned char* ws; const float* aux; float* xo;
    __device__ __forceinline__ constexpr bool perm() const { return KIND == 1 || KIND == 2 || KIND == 4; }
    __device__ __forceinline__ constexpr int mid_t() const { return KIND == 3 ? 8 : -1; }
    __device__ __forceinline__ void mid(AccM acc, const Unit& u, int wr, int wc, int fr, int fq) const { if constexpr (KIND == 3) mid_g3(acc, u, wr, fr, ws); }
    __device__ __forceinline__ void operator()(AccC acc, const Unit& u, int wr, int wc, int fr, int fq) const {
        if constexpr (KIND == 1) epi_g1(acc, u, wr, wc, fr, fq, ws);
        else if constexpr (KIND == 2) epi_g2(acc, u, wr, wc, fr, fq, ws, aux);
        else if constexpr (KIND == 4) epi_g4(acc, u, wr, wc, fr, fq, ws);
        else epi_res(acc, u, wr, wc, fr, fq, ws, aux, xo);
    }
};

struct Args { const float* in[24]; float* out; unsigned char* ws; int ph_lo, ph_hi, flags, pad; };
struct Env {
    volatile LAS unsigned* pt;
    __device__ __forceinline__ unsigned long long ptr(int i) const { const unsigned lo = pt[2 * i], hi = pt[2 * i + 1];
        return ((unsigned long long)(unsigned)__builtin_amdgcn_readfirstlane((int)hi) << 32) | (unsigned)__builtin_amdgcn_readfirstlane((int)lo); }
    __device__ __forceinline__ const float* in(int i) const { return (const float*)ptr(i); }
    __device__ __forceinline__ float* out() const { return (float*)ptr(24); }
    __device__ __forceinline__ unsigned char* ws() const { return (unsigned char*)ptr(25); }
};

__device__ __forceinline__ void p0_transpose_item(const float* W, int ldw, int K, int nblk, const float* kscale, int kslen, bf16_t* WT, LAS float* scr, int item, int lane) {
    const int kb = item / nblk, nb = item % nblk, k0 = 64 * kb, n0 = 32 * nb;
#pragma unroll 8
    for (int i = 0; i < 32; ++i) { const int kk = 2 * i + (lane >> 5); float v = W[(size_t)(k0 + kk) * ldw + n0 + (lane & 31)]; if (k0 + kk < kslen) v *= kscale[k0 + kk]; scr[kk * 33 + (lane & 31)] = v; }
    LDS_WAIT(); asm volatile("" ::: "memory");
    const int c = lane & 7;
#pragma unroll
    for (int j = 0; j < 4; ++j) { const int n = (lane >> 3) + 8 * j; const LAS float* s = scr + (8 * c) * 33 + n;
        u32x4 o; o.x = pk2(s[0 * 33], s[1 * 33]); o.y = pk2(s[2 * 33], s[3 * 33]); o.z = pk2(s[4 * 33], s[5 * 33]); o.w = pk2(s[6 * 33], s[7 * 33]);
        *(u32x4*)(WT + (size_t)(n0 + n) * K + k0 + 8 * c) = o; }
    LDS_WAIT(); asm volatile("" ::: "memory");
}
__device__ __forceinline__ void p0_weights(const Env& A, LAS unsigned char* lds, int tid, int wave, int lane) {
    unsigned char* const ws = A.ws(); const float* const i1 = A.in(1); const float* const i2 = A.in(2); const float* const i11 = A.in(11); const float* const i13 = A.in(13);
    const float* const i19 = A.in(19); const float* const i20 = A.in(20); const float* const i21 = A.in(21); const float* const i22 = A.in(22);
    LAS float* scr = (LAS float*)(lds + wave * 16384);
    const int gw = blockIdx.x * NWAVES + wave, NGW = gridDim.x * NWAVES;
    constexpr int I_IN = 16 * 80, I_GLU = 8 * 16, I_OUT = 16 * 32, I_1 = 16 * 128, I_2 = 64 * 32, I_L = I_IN + I_GLU + I_OUT + I_1 + I_2;
    for (int it = gw; it < 2 * I_L; it += NGW) {
        const int l = it / I_L; int r = it % I_L;
        unsigned char* wb = ws + WS_W + (size_t)l * W_LSTRIDE;
        if (r < I_IN) { p0_transpose_item(i2 + (size_t)l * D * DIN, DIN, D, 80, i1 + l * D, D, (bf16_t*)(wb + OFF_WIN), scr, r, lane); continue; } r -= I_IN;
        if (r < I_GLU) { p0_transpose_item(i11 + (size_t)l * DS * DS, DS, DS, 16, nullptr, 0, (bf16_t*)(wb + OFF_WGLU), scr, r, lane); continue; } r -= I_GLU;
        if (r < I_OUT) { p0_transpose_item(i19 + (size_t)l * D * D, D, D, 32, i13 + l * DS, DS, (bf16_t*)(wb + OFF_WOUT), scr, r, lane); continue; } r -= I_OUT;
        if (r < I_1) { p0_transpose_item(i21 + (size_t)l * D * DFF, DFF, D, 128, i20 + l * D, D, (bf16_t*)(wb + OFF_W1), scr, r, lane); continue; } r -= I_1;
        p0_transpose_item(i22 + (size_t)l * DFF * D, D, DFF, 32, nullptr, 0, (bf16_t*)(wb + OFF_W2), scr, r, lane);
    }
    const int gt = blockIdx.x * NTHR + tid, NGT = gridDim.x * NTHR;
    for (int idx = gt; idx < 2 * 32 * 1024; idx += NGT) {
        const int l = idx >> 15, j = (idx >> 10) & 31, k = idx & 1023;
        const float v = j < 8 ? i1[l * D + k] * i2[(size_t)l * D * DIN + (size_t)k * DIN + 2560 + j] : 0.f;
        ((bf16_t*)(ws + WS_W + (size_t)l * W_LSTRIDE + OFF_WG))[j * 1024 + k] = (bf16_t)f2bf(v);
    }
}
__device__ __forceinline__ void rpass(const float* src, unsigned char* ws, int wave, int lane) {
    const int gw = blockIdx.x * NWAVES + wave, NGW = gridDim.x * NWAVES;
    bf16_t* XB = (bf16_t*)(ws + WS_XB); float* slots = (float*)(ws + WS_SLOTS);
    for (int m = gw; m < M; m += NGW) {
        const f32x4* xr = (const f32x4*)(src + (size_t)m * D) + lane;
        f32x4 v[4]; float s = 0.f;
#pragma unroll
        for (int j = 0; j < 4; ++j) { v[j] = xr[64 * j]; s += (v[j].x * v[j].x + v[j].y * v[j].y) + (v[j].z * v[j].z + v[j].w * v[j].w); }
        s = wave_sum(s);
        u32x2* o8 = (u32x2*)(XB + (size_t)m * D) + lane;
#pragma unroll
        for (int j = 0; j < 4; ++j) { u32x2 w; w.x = pk2(v[j].x, v[j].y); w.y = pk2(v[j].z, v[j].w); o8[64 * j] = w; }
        if (lane < 16) slots[(size_t)m * 16 + lane] = lane == 0 ? s : 0.f;
    }
}
__device__ __forceinline__ void build_tables(const Env& A, int l, int g, int j, LAS unsigned char* lds, int tid) {
    LAS float* pwr = (LAS float*)lds;
    LAS float* pwi = pwr + 65 * 64;
    LAS float* bbr = pwi + 65 * 64;
    LAS float* bbi = bbr + 1024;
    LAS float* cr = bbi + 1024;
    LAS float* ci = cr + 1024;
    const int lg = l * NG + g;
    unsigned char* const ws = A.ws(); const float* const i3 = A.in(3); const float* const i4 = A.in(4); const float* const i5 = A.in(5); const float* const i6 = A.in(6);
    const float* const i7 = A.in(7); const float* const i8 = A.in(8); const float* const i9 = A.in(9);
    bf16_t* KTAB = (bf16_t*)(ws + WS_KTAB) + (size_t)g * KTAB_G;
    bf16_t* WST = (bf16_t*)(ws + WS_WST) + (size_t)g * 128 * 1024;
    bf16_t* GT = (bf16_t*)(ws + WS_GT) + (size_t)g * 1024 * 128;
    float* A64 = (float*)(ws + WS_A64);
    if (tid < 64) {
        const int n = tid;
        const float are = i3[lg * NS + n], aim = i4[lg * NS + n], dt = expf(i5[lg]);
        const float mag = expf(are * dt), abr = mag * cosf(aim * dt), abi = mag * sinf(aim * dt);
        const float den = are * are + aim * aim, zr = abr - 1.0f;
        const float sr = (zr * are + abi * aim) / den, si = (abi * are - zr * aim) / den;
#pragma unroll
        for (int q = 0; q < 16; ++q) { const float br = i6[(size_t)(lg * NS + n) * 16 + q], bi = i7[(size_t)(lg * NS + n) * 16 + q];
            bbr[n * 16 + q] = sr * br - si * bi; bbi[n * 16 + q] = sr * bi + si * br; }
        double pr = 1.0, pi = 0.0; const double ar = (double)abr, ai = (double)abi;
        for (int tau = 0; tau <= 64; ++tau) { pwr[tau * 64 + n] = (float)pr; pwi[tau * 64 + n] = (float)pi; const double t = pr * ar - pi * ai; pi = pr * ai + pi * ar; pr = t; }
        if (j == 0) { A64[(g * 64 + n) * 2] = pwr[64 * 64 + n]; A64[(g * 64 + n) * 2 + 1] = pwi[64 * 64 + n]; }
    }
    for (int i = tid; i < 1024; i += NTHR) { cr[i] = i8[(size_t)lg * 1024 + i]; ci[i] = i9[(size_t)lg * 1024 + i]; }
    __syncthreads();
    for (int e = tid; e < 2048; e += NTHR) {
        const int tau = 8 * j + (e >> 8), p = (e >> 4) & 15, q = e & 15; float acc = 0.f;
        for (int n = 0; n < 64; ++n) { const float c_r = cr[p * 64 + n], c_i = ci[p * 64 + n], p_r = pwr[tau * 64 + n], p_i = pwi[tau * 64 + n];
            const float xr = c_r * p_r - c_i * p_i, xi = c_r * p_i + c_i * p_r; acc += xr * bbr[n * 16 + q] - xi * bbi[n * 16 + q]; }
        KTAB[(tau + 1) * 256 + p * 16 + q] = (bf16_t)f2bf(acc);
    }
    if (j == 0) for (int e = tid; e < 256; e += NTHR) KTAB[e] = 0;
    for (int e = tid; e < 2048; e += NTHR) {
        const int np = 16 * j + (e >> 7), oc = e & 127, n = np & 63, im = np >> 6, k0 = oc * 8, s = k0 >> 4, q0 = k0 & 15;
        const float p_r = pwr[(63 - s) * 64 + n], p_i = pwi[(63 - s) * 64 + n]; float v[8];
#pragma unroll
        for (int jj = 0; jj < 8; ++jj) { const float b_r = bbr[n * 16 + q0 + jj], b_i = bbi[n * 16 + q0 + jj]; v[jj] = im ? (p_r * b_i + p_i * b_r) : (p_r * b_r - p_i * b_i); }
        u32x4 o; o.x = pk2(v[0], v[1]); o.y = pk2(v[2], v[3]); o.z = pk2(v[4], v[5]); o.w = pk2(v[6], v[7]);
        *(u32x4*)(WST + (size_t)np * 1024 + k0) = o;
    }
    for (int e = tid; e < 2048; e += NTHR) {
        const int rl = e >> 4, oc = e & 15, t = 8 * j + (rl >> 4), p = rl & 15, np0 = oc * 8; float v[8];
#pragma unroll
        for (int jj = 0; jj < 8; ++jj) { const int np = np0 + jj, n = np & 63; const float p_r = pwr[(t + 1) * 64 + n], p_i = pwi[(t + 1) * 64 + n], c_r = cr[p * 64 + n], c_i = ci[p * 64 + n];
            v[jj] = (np >> 6) ? -(c_r * p_i + c_i * p_r) : (c_r * p_r - c_i * p_i); }
        u32x4 o; o.x = pk2(v[0], v[1]); o.y = pk2(v[2], v[3]); o.z = pk2(v[4], v[5]); o.w = pk2(v[6], v[7]);
        *(u32x4*)(GT + (size_t)(t * 16 + p) * 128 + np0) = o;
    }
    __syncthreads();
}

__device__ __forceinline__ void s5a_item(unsigned char* ws, int g, int rb, LAS unsigned char* lds, int wave, int lane) {
    const bf16_t* U2 = (const bf16_t*)(ws + WS_U2) + ((size_t)g * M + (size_t)rb * 2048) * 16;
    const bf16_t* WST = (const bf16_t*)(ws + WS_WST) + (size_t)g * 128 * 1024;
    float* XLOC = (float*)(ws + WS_XLOC);
    const int r = lane & 31, hh = lane >> 5, nt = wave & 3, kh = wave >> 2;
    f32x16 acc; for (int i = 0; i < 16; ++i) acc[i] = 0.f;
    const bf16_t* ap = U2 + (size_t)r * 1024 + kh * 512 + 8 * hh;
    const bf16_t* bp = WST + (size_t)(nt * 32 + r) * 1024 + kh * 512 + 8 * hh;
#pragma unroll 8
    for (int ks = 0; ks < 32; ++ks) { const bf16x8 a = *(const bf16x8*)(ap + ks * 16), b = *(const bf16x8*)(bp + ks * 16); acc = MFMA32(a, b, acc); }
    LAS float* part = (LAS float*)lds + nt * 1024;
    if (kh == 1) {
#pragma unroll
        for (int reg = 0; reg < 16; ++reg) part[crow(reg, hh) * 32 + r] = acc[reg];
    }
    __syncthreads();
    if (kh == 0) {
#pragma unroll
        for (int reg = 0; reg < 16; ++reg) { const int row = crow(reg, hh), cid = rb * 32 + row; XLOC[((size_t)cid * 32 + g) * 128 + nt * 32 + r] = acc[reg] + part[row * 32 + r]; }
    }
    __syncthreads();
}
__device__ __forceinline__ void mla_item(const Env& A, int l, int cid, LAS unsigned char* lds, int tid, int wave, int lane) {
    unsigned char* const ws = A.ws(); const float* const i14 = A.in(14); const float* const i15 = A.in(15); const float* const i16 = A.in(16); const float* const i17 = A.in(17);
    const bf16_t* XB = (const bf16_t*)(ws + WS_XB);
    const bf16_t* WG = (const bf16_t*)(ws + WS_W + (size_t)l * W_LSTRIDE + OFF_WG);
    const float* slots = (const float*)(ws + WS_SLOTS);
    const bf16_t* QRAW = (const bf16_t*)(ws + WS_QRAW); const bf16_t* KRAW = (const bf16_t*)(ws + WS_KRAW); const bf16_t* VT = (const bf16_t*)(ws + WS_VT);
    bf16_t* QC = (bf16_t*)(ws + WS_QC); bf16_t* KC = (bf16_t*)(ws + WS_KC); bf16_t* DC = (bf16_t*)(ws + WS_DC);
    float* BCUM = (float*)(ws + WS_BCUM); float* AARR = (float*)(ws + WS_AARR); float* PMAX = (float*)(ws + WS_PMAX);
    float* BLAST = (float*)(ws + WS_BLAST); float* MAXG = (float*)(ws + WS_MAXG); float* NLOC = (float*)(ws + WS_NLOC);
    LAS float* gpart = (LAS float*)lds;
    LAS float* garr = gpart + 4096;
    LAS float* wts = garr + 512;
    LAS bf16_t* kT = (LAS bf16_t*)(lds + 20480);
    const int row0 = cid * 64, r = lane & 31, hh = lane >> 5;
    {
        f32x16 acc0, acc1; for (int i = 0; i < 16; ++i) { acc0[i] = 0.f; acc1[i] = 0.f; }
        const bf16_t* a0 = XB + (size_t)(row0 + r) * 1024 + wave * 128 + 8 * hh;
        const bf16_t* a1 = a0 + 32 * 1024;
        const bf16_t* bp = WG + (size_t)r * 1024 + wave * 128 + 8 * hh;
#pragma unroll
        for (int ks = 0; ks < 8; ++ks) { const bf16x8 b = *(const bf16x8*)(bp + ks * 16); acc0 = MFMA32(*(const bf16x8*)(a0 + ks * 16), b, acc0); acc1 = MFMA32(*(const bf16x8*)(a1 + ks * 16), b, acc1); }
        if (r < 8) {
#pragma unroll
            for (int reg = 0; reg < 16; ++reg) { gpart[(wave * 64 + crow(reg, hh)) * 8 + r] = acc0[reg]; gpart[(wave * 64 + 32 + crow(reg, hh)) * 8 + r] = acc1[reg]; }
        }
    }
    __syncthreads();
    {   const int t = tid & 63, j = tid >> 6; float s = 0.f;
#pragma unroll
        for (int w = 0; w < 8; ++w) s += gpart[(w * 64 + t) * 8 + j];
        const float rs = rsqrtf(sum16(slots + (size_t)(row0 + t) * 16) * (1.0f / D) + EPS);
        garr[j * 64 + t] = s * rs; }
    __syncthreads();
    if (wave < 4) {
        const int h = wave, t = lane, item = cid * 4 + h;
        const float ig = garr[h * 64 + t] + i16[l * NH + h];
        const float lf = logsigmoid_f(garr[(4 + h) * 64 + t] + i17[l * NH + h]);
        float bc = lf;
#pragma unroll
        for (int o = 1; o < 64; o <<= 1) { const float v = __shfl_up(bc, o); if (lane >= o) bc += v; }
        const float a = ig - bc; float pm = a;
#pragma unroll
        for (int o = 1; o < 64; o <<= 1) { const float v = __shfl_up(pm, o); if (lane >= o) pm = fmaxf(pm, v); }
        const float amax = __shfl(pm, 63), blast = __shfl(bc, 63);
        BCUM[item * 64 + t] = bc; AARR[item * 64 + t] = a; PMAX[item * 64 + t] = pm;
        if (lane == 0) { BLAST[item] = blast; MAXG[item] = blast + amax; }
        wts[h * 64 + t] = __expf(a - amax);
    }
    __syncthreads();
    const float* cw = i14 + l * 4 * 1024; const float* cb = i15 + l * 1024;
    const float kscale = 0.08838834764831845f;
    for (int h = 0; h < NH; ++h) {
        const int item = cid * 4 + h;
        {
            const int ch2 = tid & 63, rg = tid >> 6, c = h * DH + 2 * ch2;
            float wq0[4], wq1[4], wk0[4], wk1[4];
#pragma unroll
            for (int jj = 0; jj < 4; ++jj) { wq0[jj] = cw[jj * 1024 + c]; wq1[jj] = cw[jj * 1024 + c + 1]; wk0[jj] = cw[jj * 1024 + 512 + c]; wk1[jj] = cw[jj * 1024 + 512 + c + 1]; }
            const float bq0 = cb[c], bq1 = cb[c + 1], bk0 = cb[512 + c], bk1 = cb[512 + c + 1];
            float rq0[11], rq1[11], rk0[11], rk1[11];
#pragma unroll
            for (int i = 0; i < 11; ++i) {
                const int tl = rg * 8 - 3 + i; const bool valid = (tl >= 0) || ((cid & (CPB - 1)) != 0);
                unsigned uq = 0u, uk = 0u;
                if (valid) { uq = *(const unsigned*)(QRAW + (size_t)(row0 + tl) * 512 + c); uk = *(const unsigned*)(KRAW + (size_t)(row0 + tl) * 512 + c); }
                rq0[i] = bf2f(uq & 0xffffu); rq1[i] = bf2f(uq >> 16); rk0[i] = bf2f(uk & 0xffffu); rk1[i] = bf2f(uk >> 16);
            }
#pragma unroll
            for (int i = 0; i < 8; ++i) {
                const int t = rg * 8 + i;
                float aq0 = bq0, aq1 = bq1, ak0 = bk0, ak1 = bk1;
#pragma unroll
                for (int jj = 0; jj < 4; ++jj) { aq0 += wq0[jj] * rq0[i + jj]; aq1 += wq1[jj] * rq1[i + jj]; ak0 += wk0[jj] * rk0[i + jj]; ak1 += wk1[jj] * rk1[i + jj]; }
                const float q0 = aq0 * sigmoid_f(aq0), q1 = aq1 * sigmoid_f(aq1), k0 = ak0 * sigmoid_f(ak0) * kscale, k1 = ak1 * sigmoid_f(ak1) * kscale;
                *(unsigned*)(QC + (size_t)(row0 + t) * 512 + c) = pk2(q0, q1);
                const unsigned kb = pk2(k0, k1);
                *(unsigned*)(KC + (size_t)(row0 + t) * 512 + c) = kb;
                const float wt = wts[h * 64 + t];
                kT[(2 * ch2) * 72 + t] = (bf16_t)f2bf(wt * bf2f(kb & 0xffffu)); kT[(2 * ch2 + 1) * 72 + t] = (bf16_t)f2bf(wt * bf2f(kb >> 16));
            }
        }
        __syncthreads();
        {
            const int mt = wave >> 1, ntp = (wave & 1) * 2;
            f32x16 c0, c1; for (int i = 0; i < 16; ++i) { c0[i] = 0.f; c1[i] = 0.f; }
            const bf16_t* ap = VT + ((size_t)item * 128 + mt * 32 + r) * 64 + 8 * hh;
#pragma unroll
            for (int ks = 0; ks < 4; ++ks) {
                const bf16x8 a = *(const bf16x8*)(ap + ks * 16);
                const bf16x8 b0 = *(const LAS bf16x8*)(kT + (ntp * 32 + r) * 72 + ks * 16 + 8 * hh), b1 = *(const LAS bf16x8*)(kT + ((ntp + 1) * 32 + r) * 72 + ks * 16 + 8 * hh);
                c0 = MFMA32(a, b0, c0); c1 = MFMA32(a, b1, c1);
            }
            bf16_t* dc = DC + (size_t)item * 16384;
#pragma unroll
            for (int reg = 0; reg < 16; ++reg) { const int dv = mt * 32 + crow(reg, hh); dc[dv * 128 + ntp * 32 + r] = (bf16_t)f2bf(c0[reg]); dc[dv * 128 + (ntp + 1) * 32 + r] = (bf16_t)f2bf(c1[reg]); }
            if (tid < DH) { float s = 0.f; for (int t = 0; t < 64; ++t) s += bf2f(kT[tid * 72 + t]); NLOC[(size_t)item * DH + tid] = s; }
        }
        __syncthreads();
    }
}

__device__ __forceinline__ void m2_scans(unsigned char* ws, int tid) {
    const bf16_t* DC = (const bf16_t*)(ws + WS_DC); bf16_t* CST = (bf16_t*)(ws + WS_CST);
    const float* BLAST = (const float*)(ws + WS_BLAST); const float* MAXG = (const float*)(ws + WS_MAXG); float* MST = (float*)(ws + WS_MST);
    const float* NLOC = (const float*)(ws + WS_NLOC);
    const float* XLOC = (const float*)(ws + WS_XLOC); bf16_t* XPREV = (bf16_t*)(ws + WS_XPREV); const float* A64 = (const float*)(ws + WS_A64);
    constexpr int NC = NH * 2 * DH * DH, NN = NH * 2 * DH, NX = 2 * NG * NS;
    const int gt = blockIdx.x * NTHR + tid, NGT = gridDim.x * NTHR;
    for (int it = gt; it < NC + NN + NX; it += NGT) {
        if (it < NC + NN) {
            const bool isn = it >= NC;
            const int e = isn ? it - NC : it, bh = isn ? (e >> 7) : (e >> 14), idx = isn ? (e & 127) : (e & 16383), b = bh >> 2, h = bh & 3;
            float Cp = 0.f, mp = 0.f;
            for (int c0 = 0; c0 < CPB; c0 += 8) {
                float v[8], bl[8], mg[8];
#pragma unroll
                for (int u = 0; u < 8; ++u) { const int item = (b * CPB + c0 + u) * 4 + h; v[u] = isn ? NLOC[(size_t)item * DH + idx] : bf2f(DC[(size_t)item * 16384 + idx]); bl[u] = BLAST[item]; mg[u] = MAXG[item]; }
#pragma unroll
                for (int u = 0; u < 8; ++u) {
                    const int item = (b * CPB + c0 + u) * 4 + h;
                    CST[(size_t)item * CSTR + (isn ? 16384 + idx : idx)] = (bf16_t)f2bf(Cp);
                    if (!isn && idx == 0) MST[item] = mp;
                    const float mn = fmaxf(bl[u] + mp, mg[u]);
                    Cp = __expf(bl[u] + mp - mn) * Cp + __expf(mg[u] - mn) * v[u]; mp = mn;
                }
            }
        } else {
            const int e = it - NC - NN, b = e >> 11, g = (e >> 6) & 31, n = e & 63;
            const float ar = A64[(g * 64 + n) * 2], ai = A64[(g * 64 + n) * 2 + 1]; float xr = 0.f, xi = 0.f;
            for (int c0 = 0; c0 < CPB; c0 += 8) {
                float lr[8], li[8];
#pragma unroll
                for (int u = 0; u < 8; ++u) { const size_t base = ((size_t)(b * CPB + c0 + u) * 32 + g) * 128; lr[u] = XLOC[base + n]; li[u] = XLOC[base + 64 + n]; }
#pragma unroll
                for (int u = 0; u < 8; ++u) { const size_t base = ((size_t)(b * CPB + c0 + u) * 32 + g) * 128;
                    XPREV[base + n] = (bf16_t)f2bf(xr); XPREV[base + 64 + n] = (bf16_t)f2bf(xi);
                    const float nr = ar * xr - ai * xi + lr[u], ni = ar * xi + ai * xr + li[u]; xr = nr; xi = ni; }
            }
        }
    }
}

constexpr int USTR = 2048 + 16, S5C_KT = 32 * USTR, S5C_XP = S5C_KT + 65 * 512, XPSTR = 256 + 16;
static_assert(S5C_XP + 32 * XPSTR <= RING_BYTES, "S5c LDS");
__device__ __forceinline__ void s5c_item(const Env& A, int l, int g, int rb, LAS unsigned char* lds, int tid, int wave, int lane) {
    unsigned char* const ws = A.ws(); const float* const i10 = A.in(10);
    const unsigned char* U2b = (const unsigned char*)((const bf16_t*)(ws + WS_U2) + ((size_t)g * M + (size_t)rb * 2048) * 16);
    const unsigned char* KTb = (const unsigned char*)((const bf16_t*)(ws + WS_KTAB) + (size_t)g * KTAB_G);
    const bf16_t* XPREV = (const bf16_t*)(ws + WS_XPREV);
    const bf16_t* GT = (const bf16_t*)(ws + WS_GT) + (size_t)g * 1024 * 128;
    bf16_t* Z = (bf16_t*)(ws + WS_Z);
    for (int i = tid; i < 4096; i += NTHR) { const int rr = i >> 7, c = i & 127; *(LAS u32x4*)(lds + rr * USTR + c * 16) = *(const u32x4*)(U2b + (size_t)i * 16); }
    for (int i = tid; i < 2080; i += NTHR) *(LAS u32x4*)(lds + S5C_KT + i * 16) = *(const u32x4*)(KTb + (size_t)i * 16);
    { const int rr = tid >> 4, c = tid & 15; *(LAS u32x4*)(lds + S5C_XP + rr * XPSTR + c * 16) = *(const u32x4*)(XPREV + ((size_t)(rb * 32 + rr) * 32 + g) * 128 + c * 8); }
    __syncthreads();
    const int r = lane & 31, hh = lane >> 5, tsub = r >> 4, p = r & 15;
    int tt[4]; tt[0] = wave; tt[1] = 15 - wave; tt[2] = 16 + wave; tt[3] = 31 - wave;
    f32x16 acc[4];
#pragma unroll
    for (int j = 0; j < 4; ++j) for (int i = 0; i < 16; ++i) acc[j][i] = 0.f;
    const LAS unsigned char* ua = lds + r * USTR + hh * 16;
    const LAS unsigned char* kb = lds + S5C_KT + p * 32 + hh * 16;
#pragma unroll 2
    for (int s = 0; s < 64; ++s) {
        const bf16x8 a = *(const LAS bf16x8*)(ua + s * 32);
#pragma unroll
        for (int j = 0; j < 4; ++j) if (s <= 2 * tt[j] + 1) { const int tau1 = 2 * tt[j] + tsub - s + 1; const bf16x8 b = *(const LAS bf16x8*)(kb + tau1 * 512); acc[j] = MFMA32(a, b, acc[j]); }
    }
    const LAS unsigned char* xa = lds + S5C_XP + r * XPSTR + hh * 16;
#pragma unroll
    for (int ks = 0; ks < 8; ++ks) {
        const bf16x8 a = *(const LAS bf16x8*)(xa + ks * 32);
#pragma unroll
        for (int j = 0; j < 4; ++j) { const bf16x8 b = *(const bf16x8*)(GT + (size_t)(tt[j] * 32 + r) * 128 + ks * 16 + 8 * hh); acc[j] = MFMA32(a, b, acc[j]); }
    }
    const float dd = i10[(l * NG + g) * 16 + p];
#pragma unroll
    for (int j = 0; j < 4; ++j) {
        const int t = 2 * tt[j] + tsub;
#pragma unroll
        for (int reg = 0; reg < 16; ++reg) {
            const int row = crow(reg, hh);
            const float uv = bf2f(*(const LAS bf16_t*)(lds + row * USTR + (t * 16 + p) * 2));
            const float y = acc[j][reg] + dd * uv;
            Z[((size_t)(rb * 32 + row) * 64 + t) * 512 + g * 16 + p] = (bf16_t)f2bf(gelu_tanh(y));
        }
    }
    __syncthreads();
}
constexpr int PSTR = 72;
__device__ __forceinline__ void mlc_item(const Env& A, int l, int item, LAS unsigned char* lds, int tid, int wave, int lane) {
    unsigned char* const ws = A.ws(); const float* const i18 = A.in(18);
    const int cid = item >> 2, h = item & 3, row0 = cid * 64, r = lane & 31, hh = lane >> 5;
    const bf16_t* QC = (const bf16_t*)(ws + WS_QC) + (size_t)row0 * 512 + h * DH;
    const bf16_t* KC = (const bf16_t*)(ws + WS_KC) + (size_t)row0 * 512 + h * DH;
    const bf16_t* VT = (const bf16_t*)(ws + WS_VT) + (size_t)item * 128 * 64;
    const bf16_t* CST = (const bf16_t*)(ws + WS_CST) + (size_t)item * CSTR;
    const bf16_t* ORAW = (const bf16_t*)(ws + WS_ORAW) + (size_t)row0 * 512 + h * DH;
    bf16_t* YCAT = (bf16_t*)(ws + WS_YCAT) + (size_t)row0 * 1024 + 512 + h * DH;
    LAS float* sc = (LAS float*)lds;
    LAS float* emt = sc + 64;
    LAS float* Mtl = emt + 64;
    LAS float* al = Mtl + 64;
    LAS float* den2 = al + 64;
    LAS float* rsum = den2 + 64;
    LAS float* hsq = rsum + 128;
    LAS bf16_t* P = (LAS bf16_t*)(lds + 4096);
    if (tid < 64) {
        const int t = tid; const float bc = ((const float*)(ws + WS_BCUM))[item * 64 + t], a = ((const float*)(ws + WS_AARR))[item * 64 + t], pm = ((const float*)(ws + WS_PMAX))[item * 64 + t];
        const float mst = ((const float*)(ws + WS_MST))[item];
        const float Mt = fmaxf(mst, pm);
        sc[t] = __expf(mst - Mt); emt[t] = __expf(-bc - Mt); Mtl[t] = Mt; al[t] = a; rsum[64 + t] = 0.f;
    }
    __syncthreads();
    const int mt = wave >> 2, nt = wave & 3;
    f32x16 accQ, accN; for (int i = 0; i < 16; ++i) { accQ[i] = 0.f; accN[i] = 0.f; }
    {
        const bf16_t* ap = QC + (size_t)(mt * 32 + r) * 512 + 8 * hh;
        const bf16_t* bp = CST + (size_t)(nt * 32 + r) * 128 + 8 * hh;
        const bf16_t* bn = CST + (size_t)(128 + r) * 128 + 8 * hh;
#pragma unroll
        for (int ks = 0; ks < 8; ++ks) {
            const bf16x8 a = *(const bf16x8*)(ap + ks * 16), b = *(const bf16x8*)(bp + ks * 16);
            accQ = MFMA32(a, b, accQ);
            if (nt == 0) { const bf16x8 b2 = *(const bf16x8*)(bn + ks * 16); accN = MFMA32(a, b2, accN); }
        }
        if (nt == 0 && r == 0) {
#pragma unroll
            for (int reg = 0; reg < 16; ++reg) den2[mt * 32 + crow(reg, hh)] = accN[reg];
        }
#pragma unroll
        for (int reg = 0; reg < 16; ++reg) accQ[reg] *= sc[mt * 32 + crow(reg, hh)];
    }
    if (wave < 3) {
        const int st = wave == 2 ? 1 : 0, tq = wave == 0 ? 0 : 1;
        f32x16 accS; for (int i = 0; i < 16; ++i) accS[i] = 0.f;
        const bf16_t* ap = KC + (size_t)(st * 32 + r) * 512 + 8 * hh;
        const bf16_t* bp = QC + (size_t)(tq * 32 + r) * 512 + 8 * hh;
#pragma unroll
        for (int ks = 0; ks < 8; ++ks) { const bf16x8 a = *(const bf16x8*)(ap + ks * 16), b = *(const bf16x8*)(bp + ks * 16); accS = MFMA32(a, b, accS); }
        const int t = tq * 32 + r; const float Mt = Mtl[t]; float rs = 0.f;
#pragma unroll
        for (int reg = 0; reg < 16; ++reg) {
            const int s = st * 32 + crow(reg, hh);
            const float w = (s <= t) ? __expf(al[s] - Mt) : 0.f;
            const float pv = accS[reg] * w; rs += pv;
            P[t * PSTR + s] = (bf16_t)f2bf(pv);
        }
        rs += __shfl_xor(rs, 32);
        if (hh == 0) rsum[st * 64 + t] = rs;
    }
    __syncthreads();
    {
        const LAS bf16_t* pa = P + (mt * 32 + r) * PSTR + 8 * hh;
        const bf16_t* bp = VT + (size_t)(nt * 32 + r) * 64 + 8 * hh;
        const int nks = 2 * (mt + 1);
        for (int ks = 0; ks < nks; ++ks) { const bf16x8 a = *(const LAS bf16x8*)(pa + ks * 16), b = *(const bf16x8*)(bp + ks * 16); accQ = MFMA32(a, b, accQ); }
    }
    const int dv = nt * 32 + r;
#pragma unroll
    for (int reg = 0; reg < 16; ++reg) {
        const int t = mt * 32 + crow(reg, hh);
        const float den = rsum[t] + rsum[64 + t] + sc[t] * den2[t];
        const float hv = accQ[reg] / fmaxf(fabsf(den), emt[t]);
        const float o = sigmoid_f(bf2f(ORAW[(size_t)t * 512 + dv]));
        const float ho = o * hv; accQ[reg] = ho;
        float sq = ho * ho;
        sq += __shfl_xor(sq, 1); sq += __shfl_xor(sq, 2); sq += __shfl_xor(sq, 4); sq += __shfl_xor(sq, 8); sq += __shfl_xor(sq, 16);
        if (r == 0) hsq[nt * 64 + t] = sq;
    }
    __syncthreads();
    const float gg = i18[l * 512 + h * DH + dv];
#pragma unroll
    for (int reg = 0; reg < 16; ++reg) {
        const int t = mt * 32 + crow(reg, hh);
        const float rsn = rsqrtf(((hsq[t] + hsq[64 + t]) + (hsq[128 + t] + hsq[192 + t])) * (1.0f / DH) + EPS);
        YCAT[(size_t)t * 1024 + dv] = (bf16_t)f2bf(accQ[reg] * rsn * gg);
    }
    __syncthreads();
}
__device__ __forceinline__ void final_norm(const Env& A, int wave, int lane) {
    const int gw = blockIdx.x * NWAVES + wave, NGW = gridDim.x * NWAVES;
    const float* slots = (const float*)(A.ws() + WS_SLOTS); const f32x4* gv = (const f32x4*)A.in(23) + lane; float* const xo = A.out();
    for (int m = gw; m < M; m += NGW) {
        f32x4* xr = (f32x4*)(xo + (size_t)m * D) + lane;
        const float rs = rsqrtf(sum16(slots + (size_t)m * 16) * (1.0f / D) + EPS);
#pragma unroll
        for (int j = 0; j < 4; ++j) { const f32x4 v = xr[64 * j]; xr[64 * j] = v * rs * gv[64 * j]; }
    }
}

constexpr int N_PHASES = 18;
#ifndef MK_PHMASK
#define MK_PHMASK 0x3ff
#endif
#define PHEN(i) (((MK_PHMASK) >> (i)) & 1)
__global__ void __launch_bounds__(NTHR, 2) mega_fwd(Args args) {
    extern __shared__ __attribute__((aligned(16))) unsigned char lds_raw[];
    LAS unsigned char* lds = (LAS unsigned char*)lds_raw;
    volatile LAS unsigned* MISC = (volatile LAS unsigned*)(lds + MISC_OFF);
    volatile LAS unsigned* PT = (volatile LAS unsigned*)(lds + MISC_OFF - 256);
    if (threadIdx.x < 64) MISC[threadIdx.x] = 0u;
    if (threadIdx.x == 0) {
#pragma unroll
        for (int i = 0; i < 24; ++i) { const unsigned long long v = (unsigned long long)args.in[i]; PT[2 * i] = (unsigned)v; PT[2 * i + 1] = (unsigned)(v >> 32); }
        { const unsigned long long v = (unsigned long long)args.out; PT[48] = (unsigned)v; PT[49] = (unsigned)(v >> 32); }
        { const unsigned long long v = (unsigned long long)args.ws; PT[50] = (unsigned)v; PT[51] = (unsigned)(v >> 32); }
    }
    __syncthreads();
    Env A; A.pt = PT;
    const int wave0 = __builtin_amdgcn_readfirstlane(threadIdx.x >> 6);
    XcdBarrier bar = xcd_barrier_post((unsigned*)(args.ws + WS_CTL) + CW_BAR, MISC + 8);
    const int lo = args.ph_lo, hi = args.ph_hi, flags = args.flags;
    for (int ph = lo; ph < hi; ++ph) {
        int wave = wave0; asm volatile("" : "+s"(wave));
        int lane; asm volatile("v_mbcnt_lo_u32_b32 %0, -1, 0\n\tv_mbcnt_hi_u32_b32 %0, -1, %0" : "=v"(lane));
        __builtin_assume(lane >= 0 && lane < 64); __builtin_assume(wave >= 0 && wave < 8);
        const int tid = wave * 64 + lane;
        if (ph > lo) xcd_barrier(bar, (unsigned*)(A.ws() + WS_CTL) + CW_BAR, tid == 0);
        if (ph == 0) { if (PHEN(0)) {
            p0_weights(A, lds, tid, wave, lane);
            rpass(A.in(0), A.ws(), wave, lane);
            __syncthreads();
            for (int it = blockIdx.x; it < 256; it += gridDim.x) build_tables(A, 0, it >> 3, it & 7, lds, tid); }
        } else if (ph == 17) {
            if (PHEN(9)) final_norm(A, wave, lane);
        } else {
            const int l = (ph - 1) >> 3, k = (ph - 1) & 7;
            unsigned char* const ws = A.ws();
            if (k == 1) { if (PHEN(2)) {
                for (int it = blockIdx.x; it < 256; it += gridDim.x) s5a_item(ws, it & 31, it >> 5, lds, wave, lane);
                for (int it = blockIdx.x; it < NCHUNK; it += gridDim.x) mla_item(A, l, it, lds, tid, wave, lane); }
            } else if (k == 2) {
                if (PHEN(3)) m2_scans(ws, tid);
            } else if (k == 3) { if (PHEN(4)) {
                for (int it = blockIdx.x; it < 256; it += gridDim.x) s5c_item(A, l, it & 31, it >> 5, lds, tid, wave, lane);
                for (int it = blockIdx.x; it < NITEM; it += gridDim.x) mlc_item(A, l, it, lds, tid, wave, lane); }
            } else {
#define LAUNDER_TD() int wv = wave0; asm volatile("" : "+s"(wv)); int ln; asm volatile("v_mbcnt_lo_u32_b32 %0, -1, 0\n\tv_mbcnt_hi_u32_b32 %0, -1, %0" : "=v"(ln)); __builtin_assume(ln >= 0 && ln < 64); __builtin_assume(wv >= 0 && wv < 8); const int td = wv * 64 + ln
                unsigned char* const wb = ws + WS_W + (size_t)l * W_LSTRIDE;
                if (k == 0) { if (PHEN(1)) {
                    if ((flags & 1) && ph == lo && l == 1) { rpass(A.out(), ws, wave, lane); xcd_barrier(bar, (unsigned*)(ws + WS_CTL) + CW_BAR, tid == 0); }
                    pg8::Gemm g{(const bf16_t*)(ws + WS_XB), (const bf16_t*)(wb + OFF_WIN), M, NP, D}; pg8::StaticOrder S; S.init(M, NP, gridDim.x, blockIdx.x);
                    EpiK<1> E{ws, nullptr, nullptr}; LAUNDER_TD();
                    pg8::gemm_phase<EpiK<1>, pg8::StaticOrder, true, true>(lds, g, S, E, td); }
                } else if (k == 4) { if (PHEN(5)) {
                    pg8::Gemm g{(const bf16_t*)(ws + WS_Z), (const bf16_t*)(wb + OFF_WGLU), M, DS, DS}; pg8::StaticOrder S; S.init(M, DS, gridDim.x, blockIdx.x);
                    EpiK<2> E{ws, A.in(12) + l * DS, nullptr}; LAUNDER_TD();
                    pg8::gemm_phase<EpiK<2>, pg8::StaticOrder, true, true>(lds, g, S, E, td);
                    if (l == 0) {
                        __syncthreads();
                        const int nfree = (int)gridDim.x > 128 ? (int)gridDim.x - 128 : (int)gridDim.x, first = (int)gridDim.x > 128 ? 128 : 0;
                        if ((int)blockIdx.x >= first) for (int it = blockIdx.x - first; it < 256; it += nfree) build_tables(A, 1, it >> 3, it & 7, lds, tid);
                    } }
                } else if (k == 5) { if (PHEN(6)) {
                    pg8::Gemm g{(const bf16_t*)(ws + WS_YCAT), (const bf16_t*)(wb + OFF_WOUT), M, D, D}; pg8::StaticOrder S; S.init(M, D, gridDim.x, blockIdx.x);
                    float* const xo = A.out();
                    EpiK<3> E{ws, l == 0 ? A.in(0) : (const float*)xo, xo}; LAUNDER_TD();
                    pg8::gemm_phase<EpiK<3>, pg8::StaticOrder, true, true>(lds, g, S, E, td); }
                } else if (k == 6) { if (PHEN(7)) {
                    pg8::Gemm g{(const bf16_t*)(ws + WS_XB), (const bf16_t*)(wb + OFF_W1), M, DFF, D}; pg8::StaticOrder S; S.init(M, DFF, gridDim.x, blockIdx.x);
                    EpiK<4> E{ws, nullptr, nullptr}; LAUNDER_TD();
                    pg8::gemm_phase<EpiK<4>, pg8::StaticOrder, true, true>(lds, g, S, E, td); }
                } else { if (PHEN(8)) {
                    pg8::Gemm g{(const bf16_t*)(ws + WS_H1), (const bf16_t*)(wb + OFF_W2), M, D, DFF}; pg8::StaticOrder S; S.init(M, D, gridDim.x, blockIdx.x);
                    float* const xo = A.out();
                    EpiK<5> E{ws, xo, xo}; LAUNDER_TD();
                    pg8::gemm_phase<EpiK<5>, pg8::StaticOrder, true, true>(lds, g, S, E, td); }
                }
            }
        }
    }
}

extern "C" void kernel_launch(void* const* d_in, const int* in_sizes, int n_in, void* d_out, int out_size, void* d_ws, size_t ws_size, hipStream_t stream) {
    static int grid = 0;
    if (grid == 0) {
        if (n_in != 24 || out_size != M * D || ws_size < WS_END) { fprintf(stderr, "kernel_launch: unexpected problem shape (n_in %d out %d ws %zu)\n", n_in, out_size, ws_size); grid = -1; return; }
        int dev = 0, cus = 0, per_cu = 0;
        if (hipGetDevice(&dev) != hipSuccess || hipDeviceGetAttribute(&cus, hipDeviceAttributeMultiprocessorCount, dev) != hipSuccess) { grid = -1; return; }
        if (hipFuncSetAttribute((const void*)mega_fwd, hipFuncAttributeMaxDynamicSharedMemorySize, LDS_BYTES) != hipSuccess) { fprintf(stderr, "kernel_launch: hipFuncSetAttribute failed\n"); grid = -1; return; }
        if (hipOccupancyMaxActiveBlocksPerMultiprocessor(&per_cu, (const void*)mega_fwd, NTHR, LDS_BYTES) != hipSuccess || per_cu < 1) { fprintf(stderr, "kernel_launch: occupancy query says %d\n", per_cu); per_cu = 1; }
        (void)hipGetLastError();
        grid = cus;
    }
    if (grid < 0) return;
    (void)hipMemsetAsync((char*)d_ws + WS_CTL, 0, CTL_ZERO_BYTES, stream);
    Args a{};
    for (int i = 0; i < 24; ++i) a.in[i] = (const float*)d_in[i];
    a.out = (float*)d_out; a.ws = (unsigned char*)d_ws; a.flags = 0; a.pad = 0;
#ifndef MK_SPLIT
    a.ph_lo = 0; a.ph_hi = N_PHASES;
    hipLaunchKernelGGL(mega_fwd, dim3(grid), dim3(NTHR), LDS_BYTES, stream, a);
#else
    for (int ph = 0; ph < N_PHASES; ++ph) { a.ph_lo = ph; a.ph_hi = ph + 1; hipLaunchKernelGGL(mega_fwd, dim3(grid), dim3(NTHR), LDS_BYTES, stream, a); }
#endif
}
```

```cpp
#include <hip/hip_runtime.h>
#include <cstdio>
#include <cstdint>
namespace pg8 {
#define PG8_LAS __attribute__((address_space(3)))
typedef unsigned short bf16_t;
typedef short bf16x8 __attribute__((ext_vector_type(8)));
typedef float f32x4 __attribute__((ext_vector_type(4)));
typedef unsigned u32x4 __attribute__((ext_vector_type(4)));
constexpr int BM = 256, BK = 64, HALF = 128, HTB = HALF * BK * 2  , STAGE_BYTES = 8 * HTB, NXCD = 8, WGM = 8;

__host__ __device__ __forceinline__ int lds_byte(int r, int c) { const int st = (r >> 4) * 2 + (c >> 5), rr = r & 15, cc = c & 31, ob = rr * 64 + cc * 2; return st * 1024 + (ob ^ (((ob >> 9) & 1) << 5)); }
__host__ __device__ __forceinline__ void stage_rc(int b, int& R, int& C) { const int st = b / 1024, sb = b % 1024, swz = sb ^ (((sb >> 9) & 1) << 5); R = (st >> 1) * 16 + swz / 64; C = (st & 1) * 32 + (swz % 64) / 2; }
__host__ __device__ __forceinline__ int perm32(int rho) { const int n = rho >> 4, i = rho & 15; return 8 * (i >> 2) + 4 * n + (i & 3); }

struct Unit { int pm, pn; };
struct Gemm { const bf16_t* A; const bf16_t* Bt; int M, N, K; };

struct StaticOrder {
    int nM, nN, nwg, G, c;
    __host__ __device__ void init(int M, int N, int G_, int c_) { nM = M / BM; nN = N / BM; nwg = nM * nN; G = G_; c = c_; }
    __host__ __device__ bool next(int i, Unit& u) const {
        const long L = (long)i * G + c; if (L >= nwg) return false;
        int wgid = (int)L; { const int q = nwg / NXCD, r = nwg % NXCD, xcd = wgid % NXCD, off = wgid / NXCD; wgid = (xcd < r ? xcd * (q + 1) : r * (q + 1) + (xcd - r) * q) + off; }
        const int nig = WGM * nN, gid = wgid / nig, fm = gid * WGM, gsz = (nM - fm) < WGM ? (nM - fm) : WGM;
        u.pm = fm + ((wgid % nig) % gsz); u.pn = (wgid % nig) / gsz; return true;
    }
    __device__ __forceinline__ void a_ready(const Unit&) const {}
    __device__ __forceinline__ void done(const Unit&) const {}
};
__device__ __forceinline__ unsigned cvt_pk_bf16(float lo, float hi) { unsigned r; asm volatile("v_cvt_pk_bf16_f32 %0, %1, %2" : "=v"(r) : "v"(lo), "v"(hi)); return r; }

template <class Epi, class Sched, bool ALIGN_EPI = false, bool SP2 = false>
__device__ __forceinline__ void gemm_phase(PG8_LAS unsigned char* lds, const Gemm g, const Sched& S, const Epi& E, const int tid) {
    const int wid = __builtin_amdgcn_readfirstlane(tid >> 6), lane = tid & 63, wr = wid >> 2, wc = wid & 3, fr = lane & 15, fq = lane >> 4;
    const int K = g.K, nt = K / BK;
    unsigned voffA[2], voffB[2];
#pragma unroll
    for (int i = 0; i < 2; ++i) { int R, C; stage_rc(tid * 16 + i * 8192, R, C); const int Rb = E.perm() ? ((R & ~31) + perm32(R & 31)) : R;
        voffA[i] = (unsigned)(R * K + C) * 2u; voffB[i] = (unsigned)(Rb * K + C) * 2u; }
    const size_t kstep = (size_t)(BK * 2);
    const size_t hstep = (size_t)HALF * K * 2;
    const size_t tstep = 2 * hstep;
    const unsigned ldsw = (unsigned)wid * 1024u;
    const int aoff = lds_byte(wr * 64 + fr, fq * 8), boff = lds_byte(wc * 32 + fr, fq * 8);
#define PG8_SA(b, h) (((b) * 2 + (h)) * HTB)
#define PG8_SB(b, h) ((4 + (b) * 2 + (h)) * HTB)
#define PG8_STAGE(bufoff, gbase, voff) do { _Pragma("unroll") for (int _i = 0; _i < 2; ++_i) \
        __builtin_amdgcn_global_load_lds((const unsigned*)((const char*)(gbase) + (voff)[_i]), (PG8_LAS unsigned*)(lds + (bufoff) + ldsw + _i * 8192), 16, 0, 0); } while (0)
#define PG8_LDA(dst, b, h) do { _Pragma("unroll") for (int m = 0; m < 4; ++m) _Pragma("unroll") for (int k = 0; k < 2; ++k) dst[m][k] = *(const PG8_LAS bf16x8*)(lds + PG8_SA(b, h) + aoff + m * 2048 + k * 1024); } while (0)
#define PG8_LDB(dst, b, h) do { _Pragma("unroll") for (int n = 0; n < 2; ++n) _Pragma("unroll") for (int k = 0; k < 2; ++k) dst[n][k] = *(const PG8_LAS bf16x8*)(lds + PG8_SB(b, h) + boff + n * 2048 + k * 1024); } while (0)
#define PG8_MMA(ai, bj, At, Bt) do { __builtin_amdgcn_s_setprio(1); _Pragma("unroll") for (int m = 0; m < 4; ++m) _Pragma("unroll") for (int n = 0; n < 2; ++n) _Pragma("unroll") for (int k = 0; k < 2; ++k) \
        acc[ai][bj][m][n] = __builtin_amdgcn_mfma_f32_16x16x32_bf16(Bt[n][k], At[m][k], acc[ai][bj][m][n], 0, 0, 0); __builtin_amdgcn_s_setprio(0); } while (0)
#define PG8_WAIT_V(n) asm volatile("s_waitcnt vmcnt(" #n ")" ::: "memory")
#define PG8_WAIT_L(n) asm volatile("s_waitcnt lgkmcnt(" #n ")" ::: "memory")
#define PG8_BAR __builtin_amdgcn_s_barrier()
#define PG8_SCHED __builtin_amdgcn_sched_barrier(0)
    Unit cur, nxt; int ui = 0;
    if (!S.next(0, cur)) return;
    f32x4 acc[2][2][4][2];
#pragma unroll
    for (int a = 0; a < 2; ++a)
#pragma unroll
        for (int b = 0; b < 2; ++b)
#pragma unroll
            for (int m = 0; m < 4; ++m)
#pragma unroll
                for (int n = 0; n < 2; ++n) acc[a][b][m][n] = (f32x4){0.f, 0.f, 0.f, 0.f};
    bf16x8 At[4][2], B0[2][2], B1[2][2];
    const char* cA = (const char*)g.A + (size_t)cur.pm * tstep; const char* cB = (const char*)g.Bt + (size_t)cur.pn * tstep;
    S.a_ready(cur);
    if constexpr (SP2) {
        PG8_STAGE(PG8_SB(0, 0), cB, voffB); PG8_STAGE(PG8_SB(0, 1), cB + hstep, voffB); PG8_STAGE(PG8_SA(0, 0), cA, voffA); PG8_STAGE(PG8_SA(0, 1), cA + hstep, voffA);
        if (wr == 1) PG8_BAR;
        PG8_WAIT_V(2); PG8_BAR;
        PG8_STAGE(PG8_SB(1, 0), cB + kstep, voffB); PG8_STAGE(PG8_SA(1, 0), cA + kstep, voffA); PG8_STAGE(PG8_SB(1, 1), cB + hstep + kstep, voffB);
        PG8_WAIT_V(6); PG8_BAR;
    } else {
        PG8_STAGE(PG8_SB(0, 0), cB, voffB); PG8_STAGE(PG8_SA(0, 0), cA, voffA); PG8_STAGE(PG8_SB(0, 1), cB + hstep, voffB); PG8_STAGE(PG8_SA(0, 1), cA + hstep, voffA);
        if (wr == 1) PG8_BAR;
        PG8_WAIT_V(4); PG8_BAR;
        PG8_STAGE(PG8_SB(1, 0), cB + kstep, voffB); PG8_STAGE(PG8_SA(1, 0), cA + kstep, voffA); PG8_STAGE(PG8_SB(1, 1), cB + hstep + kstep, voffB);
        PG8_WAIT_V(6); PG8_BAR;
    }
    for (;;) {
        const bool has_next = S.next(ui + 1, nxt);
        const char* nA = has_next ? (const char*)g.A + (size_t)nxt.pm * tstep : cA; const char* nB = has_next ? (const char*)g.Bt + (size_t)nxt.pn * tstep : cB;
        for (int t = 0; t < nt; t += 2) {
            const bool last = (t == nt - 2);
            const char* a1 = cA + (size_t)(t + 1) * kstep;
            const char* a2 = last ? nA : cA + (size_t)(t + 2) * kstep; const char* b2 = last ? nB : cB + (size_t)(t + 2) * kstep;
            const char* a3 = a2 + kstep; const char* b3 = b2 + kstep;
            if (last && has_next) S.a_ready(nxt);
            if (t == E.mid_t()) E.mid(acc, cur, wr, wc, fr, fq);
            if constexpr (SP2) {
            PG8_LDB(B0, 0, 0); PG8_LDB(B1, 0, 1); PG8_SCHED; PG8_LDA(At, 0, 0); PG8_STAGE(PG8_SA(1, 1), a1 + hstep, voffA);
            PG8_WAIT_V(8); PG8_WAIT_L(0); PG8_BAR; PG8_MMA(0, 0, At, B0); PG8_MMA(0, 1, At, B1); PG8_BAR; PG8_SCHED;
            PG8_LDA(At, 0, 1); PG8_STAGE(PG8_SB(0, 0), b2, voffB); PG8_STAGE(PG8_SB(0, 1), b2 + hstep, voffB); PG8_STAGE(PG8_SA(0, 0), a2, voffA);
            PG8_WAIT_V(8); PG8_WAIT_L(0); PG8_BAR; PG8_MMA(1, 0, At, B0); PG8_MMA(1, 1, At, B1); PG8_BAR; PG8_SCHED;
            PG8_LDB(B0, 1, 0); PG8_LDB(B1, 1, 1); PG8_SCHED; PG8_LDA(At, 1, 0); PG8_STAGE(PG8_SA(0, 1), a2 + hstep, voffA);
            PG8_WAIT_V(8); PG8_WAIT_L(0); PG8_BAR; PG8_MMA(0, 0, At, B0); PG8_MMA(0, 1, At, B1); PG8_BAR; PG8_SCHED;
            PG8_LDA(At, 1, 1); PG8_STAGE(PG8_SB(1, 0), b3, voffB); PG8_STAGE(PG8_SB(1, 1), b3 + hstep, voffB); PG8_STAGE(PG8_SA(1, 0), a3, voffA);
            PG8_WAIT_V(8); PG8_WAIT_L(0); PG8_BAR; PG8_MMA(1, 0, At, B0); PG8_MMA(1, 1, At, B1); PG8_BAR; PG8_SCHED;
            } else {
            PG8_LDB(B0, 0, 0); PG8_SCHED; PG8_LDA(At, 0, 0); PG8_STAGE(PG8_SA(1, 1), a1 + hstep, voffA);
            PG8_WAIT_L(8); PG8_BAR; PG8_WAIT_L(0); PG8_MMA(0, 0, At, B0); PG8_BAR; PG8_SCHED;
            PG8_LDB(B1, 0, 1); PG8_STAGE(PG8_SB(0, 0), b2, voffB);
            PG8_BAR; PG8_WAIT_L(0); PG8_MMA(0, 1, At, B1); PG8_BAR;
            PG8_LDA(At, 0, 1); PG8_STAGE(PG8_SA(0, 0), a2, voffA);
            PG8_BAR; PG8_WAIT_L(0); PG8_MMA(1, 0, At, B0); PG8_BAR; PG8_SCHED;
            PG8_STAGE(PG8_SB(0, 1), b2 + hstep, voffB);
            PG8_WAIT_V(6); PG8_BAR; PG8_MMA(1, 1, At, B1); PG8_BAR;
            PG8_LDB(B0, 1, 0); PG8_SCHED; PG8_LDA(At, 1, 0); PG8_STAGE(PG8_SA(0, 1), a2 + hstep, voffA);
            PG8_WAIT_L(8); PG8_BAR; PG8_WAIT_L(0); PG8_MMA(0, 0, At, B0); PG8_BAR; PG8_SCHED;
            PG8_LDB(B1, 1, 1); PG8_STAGE(PG8_SB(1, 0), b3, voffB);
            PG8_BAR; PG8_WAIT_L(0); PG8_MMA(0, 1, At, B1); PG8_BAR;
            PG8_LDA(At, 1, 1); PG8_STAGE(PG8_SA(1, 0), a3, voffA);
            PG8_BAR; PG8_WAIT_L(0); PG8_MMA(1, 0, At, B0); PG8_BAR; PG8_SCHED;
            PG8_STAGE(PG8_SB(1, 1), b3 + hstep, voffB);
            PG8_WAIT_V(6); PG8_BAR; PG8_MMA(1, 1, At, B1); PG8_BAR;
            }
        }
        if constexpr (ALIGN_EPI) { if (wr == 0) PG8_BAR; }
        if constexpr (!Epi::AFTER_DRAIN) { E(acc, cur, wr, wc, fr, fq); S.done(cur); }
        if (!has_next) break;
#pragma unroll
        for (int a = 0; a < 2; ++a)
#pragma unroll
            for (int b = 0; b < 2; ++b)
#pragma unroll
                for (int m = 0; m < 4; ++m)
#pragma unroll
                    for (int n = 0; n < 2; ++n) acc[a][b][m][n] = (f32x4){0.f, 0.f, 0.f, 0.f};
        cur = nxt; cA = nA; cB = nB; ++ui;
        if constexpr (ALIGN_EPI) { if (wr == 1) PG8_BAR; }
    }
    PG8_WAIT_V(0);
    if constexpr (!ALIGN_EPI) { if (wr == 0) PG8_BAR; }
    PG8_BAR;
    if constexpr (Epi::AFTER_DRAIN) { E.fused(acc, cur, wr, wc, fr, fq, lds, wid, lane); S.done(cur); }
#undef PG8_SA
#undef PG8_SB
#undef PG8_STAGE
#undef PG8_LDA
#undef PG8_LDB
#undef PG8_MMA
#undef PG8_WAIT_V
#undef PG8_WAIT_L
#undef PG8_BAR
#undef PG8_SCHED
}
}

#define GAS __attribute__((address_space(1)))
#define LAS __attribute__((address_space(3)))
typedef unsigned short bf16_t;
typedef short bf16x8 __attribute__((ext_vector_type(8)));
typedef float f32x4 __attribute__((ext_vector_type(4)));
typedef float f32x16 __attribute__((ext_vector_type(16)));
typedef unsigned u32x4 __attribute__((ext_vector_type(4)));
typedef unsigned u32x2 __attribute__((ext_vector_type(2)));
constexpr int NWAVES = 8, NTHR = 512;
constexpr int M = 16384, D = 1024, NP = 2560, DIN = 2568, DS = 512, NG = 32, NS = 64, NH = 4, DH = 128, DFF = 4096, NCHUNK = 256, CPB = 128, NITEM = 1024;
constexpr float EPS = 1e-6f;
constexpr size_t MiB = 1u << 20, KiB = 1024;
constexpr size_t WS_CTL = 0, CTL_ZERO_BYTES = 64 * KiB;
constexpr size_t WS_W = 1 * MiB, W_LSTRIDE = 24 * MiB;
constexpr size_t OFF_WIN = 0, OFF_WG = 5 * MiB, OFF_WGLU = 5 * MiB + 64 * KiB, OFF_WOUT = 6 * MiB, OFF_W1 = 8 * MiB, OFF_W2 = 16 * MiB;
constexpr size_t KTAB_G = 65 * 256;
constexpr size_t WS_KTAB = 49 * MiB, WS_A64 = 50 * MiB + 256 * KiB, WS_WST = 51 * MiB, WS_GT = 59 * MiB;
constexpr size_t WS_SLOTS = 67 * MiB, WS_SLOTS2 = 68 * MiB, WS_BCUM = 68 * MiB + 512 * KiB, WS_AARR = WS_BCUM + 256 * KiB, WS_PMAX = WS_AARR + 256 * KiB;
constexpr size_t WS_BLAST = WS_PMAX + 256 * KiB, WS_MAXG = WS_BLAST + 4 * KiB, WS_MST = WS_MAXG + 4 * KiB;
constexpr size_t WS_NLOC = 69 * MiB + 512 * KiB, WS_XLOC = 70 * MiB, WS_XPREV = 74 * MiB;
constexpr size_t WS_U2 = 76 * MiB, WS_QRAW = 92 * MiB, WS_Z = WS_QRAW, WS_KRAW = 108 * MiB, WS_VT = 124 * MiB, WS_ORAW = 140 * MiB, WS_QC = 156 * MiB, WS_KC = 172 * MiB;
constexpr size_t WS_DC = 188 * MiB, WS_YCAT = WS_DC, WS_XB = 220 * MiB, WS_CST = WS_XB, WS_H1 = 76 * MiB, WS_END = 253 * MiB;
constexpr size_t CSTR = 129 * 128;
static_assert(WS_CST + (size_t)NITEM * CSTR * 2 + 32 * 256 <= WS_END && WS_H1 + (size_t)M * DFF * 2 <= WS_XB && WS_BLAST + 12 * KiB <= WS_NLOC, "ws map");
constexpr int CW_BAR = 4096;
constexpr int RING_BYTES = 131072, LDS_BYTES = 160 * 1024, MISC_OFF = LDS_BYTES - 256;

#define RLX_AGENT __ATOMIC_RELAXED, __HIP_MEMORY_SCOPE_AGENT
#define LDS_WAIT() asm volatile("s_waitcnt lgkmcnt(0)" ::: "memory")
#define VM_WAIT() asm volatile("s_waitcnt vmcnt(0)" ::: "memory")
#define MFMA32(a, b, c) __builtin_amdgcn_mfma_f32_32x32x16_bf16((a), (b), (c), 0, 0, 0)
__device__ __forceinline__ float bf2f(unsigned b) { return __uint_as_float(b << 16); }
__device__ __forceinline__ unsigned f2bf(float f) { unsigned u = __float_as_uint(f); return (u + 0x7fffu + ((u >> 16) & 1u)) >> 16; }
__device__ __forceinline__ unsigned pk2(float lo, float hi) { return f2bf(lo) | (f2bf(hi) << 16); }
__device__ __forceinline__ float wave_sum(float v) {
#pragma unroll
    for (int o = 1; o < 64; o <<= 1) v += __shfl_xor(v, o);
    return v;
}
__device__ __forceinline__ float sigmoid_f(float x) { return 1.0f / (1.0f + __expf(-x)); }
__device__ __forceinline__ float logsigmoid_f(float x) { return fminf(x, 0.f) - log1pf(__expf(-fabsf(x))); }
__device__ __forceinline__ float gelu_tanh(float x) { const float u = 0.7978845608028654f * (x + 0.044715f * x * x * x); const float e = __expf(2.0f * u); const float th = 1.0f - 2.0f / (e + 1.0f); return 0.5f * x * (1.0f + th); }
__device__ __forceinline__ int crow(int reg, int hh) { return (reg & 3) + 8 * (reg >> 2) + 4 * hh; }
__device__ __forceinline__ float sum16(const float* p) { const f32x4 a = ((const f32x4*)p)[0], b = ((const f32x4*)p)[1], c = ((const f32x4*)p)[2], d = ((const f32x4*)p)[3];
    return ((a.x + a.y) + (a.z + a.w)) + ((b.x + b.y) + (b.z + b.w)) + ((c.x + c.y) + (c.z + c.w)) + ((d.x + d.y) + (d.z + d.w)); }
__device__ __forceinline__ float sum8(const float* p) { const f32x4 a = ((const f32x4*)p)[0], b = ((const f32x4*)p)[1]; return ((a.x + a.y) + (a.z + a.w)) + ((b.x + b.y) + (b.z + b.w)); }

#define XB_TMO      128
#define XB_XCNT(j)  (256  + 64 * (j))
#define XB_XSUB(j)  (1280 + 64 * (j))
#define XB_XGEN(j)  (2304 + 64 * (j))
#define XB_TOP      3328
#define XB_TOPGEN   3392
#define XCD_BAR_WORDS 3456
#define XB_SPIN_CAP (1u << 20)
__device__ __forceinline__ unsigned xb_ld(unsigned* p)              { return __hip_atomic_load(p, __ATOMIC_RELAXED, __HIP_MEMORY_SCOPE_AGENT); }
__device__ __forceinline__ unsigned xb_add(unsigned* p, unsigned v) { return __hip_atomic_fetch_add(p, v, __ATOMIC_RELAXED, __HIP_MEMORY_SCOPE_AGENT); }
__device__ __forceinline__ unsigned xb_xcc_id() { return (unsigned)__builtin_amdgcn_s_getreg((3 << 11) | 20) & 0xFu; }
#define XB_SPIN(cond, bar) do { unsigned _sp = 0; while (cond) { __builtin_amdgcn_s_sleep(1); \
    if ((++_sp & 255u) == 0u) { if (xb_ld(&(bar)[XB_TMO])) break; if (_sp > XB_SPIN_CAP) { atomicAdd(&(bar)[XB_TMO], 1u); break; } } } } while (0)
struct XcdBarrier { unsigned* bar; unsigned x; volatile LAS unsigned* st; };
__device__ __forceinline__ XcdBarrier xcd_barrier_post(unsigned* bar, volatile LAS unsigned* st) {
    XcdBarrier b; b.bar = bar; b.x = xb_xcc_id(); b.st = st;
    if (threadIdx.x == 0) (void)xb_add(&bar[XB_XCNT(b.x)], 1u);
    return b;
}
__device__ __forceinline__ void xcd_barrier_complete(unsigned* bar, unsigned x, unsigned& nloc, unsigned& nx) {
    const unsigned G = gridDim.x * gridDim.y * gridDim.z;
    unsigned sum, cnt, mine, sp = 0u;
    for (;;) {
        sum = 0u; cnt = 0u; mine = 0u;
#pragma unroll 1
        for (unsigned j = 0; j < 16; ++j) { const unsigned c = xb_ld(&bar[XB_XCNT(j)]); sum += c; cnt += (c > 0u) ? 1u : 0u; mine = (j == x) ? c : mine; }
        if (sum == G) break;
        __builtin_amdgcn_s_sleep(1);
        if ((++sp & 255u) == 0u) { if (xb_ld(&bar[XB_TMO])) break; if (sp > XB_SPIN_CAP) { atomicAdd(&bar[XB_TMO], 1u); break; } }
    }
    nloc = mine > 0u ? mine : 1u; nx = cnt > 0u ? cnt : 1u;
}
__device__ __forceinline__ void xcd_barrier(const XcdBarrier& b, unsigned* bar_in, bool leader) {
    asm volatile("s_waitcnt vmcnt(0)" ::: "memory");
    __syncthreads();
    if (leader) {
        unsigned* bar = bar_in;
        __builtin_amdgcn_s_waitcnt(0);
        unsigned nloc = b.st[0], nx = b.st[1];
        if (nloc == 0u) { xcd_barrier_complete(bar, b.x, nloc, nx); b.st[0] = nloc; b.st[1] = nx; }
        const unsigned old = xb_add(&bar[XB_XSUB(b.x)], 1u);
        const unsigned gen = old / nloc;
        if (old + 1u == (gen + 1u) * nloc) {
            __builtin_amdgcn_fence(__ATOMIC_RELEASE, "agent");
            asm volatile("s_waitcnt vmcnt(0)" ::: "memory");
            const unsigned og = xb_add(&bar[XB_TOP], 1u);
            const unsigned tg = og / nx;
            if (og + 1u == (tg + 1u) * nx) xb_add(&bar[XB_TOPGEN], 1u);
            else XB_SPIN(xb_ld(&bar[XB_TOPGEN]) == tg, bar);
            __builtin_amdgcn_fence(__ATOMIC_ACQUIRE, "agent");
            xb_add(&bar[XB_XGEN(b.x)], 1u);
            asm volatile("s_waitcnt vmcnt(0)" ::: "memory");
        } else {
            XB_SPIN(xb_ld(&bar[XB_XGEN(b.x)]) == gen, bar);
            __builtin_amdgcn_fence(__ATOMIC_ACQUIRE, "agent");
            asm volatile("s_waitcnt vmcnt(0)" ::: "memory");
        }
    }
    __syncthreads();
}

using pg8::Unit; using pg8::cvt_pk_bf16;
__device__ __forceinline__ float sum_fq(float v) {
    { auto r = __builtin_amdgcn_permlane16_swap(__float_as_uint(v), __float_as_uint(v), false, false); v = __uint_as_float(r[0]) + __uint_as_float(r[1]); }
    { auto r = __builtin_amdgcn_permlane32_swap(__float_as_uint(v), __float_as_uint(v), false, false); v = __uint_as_float(r[0]) + __uint_as_float(r[1]); }
    return v;
}
typedef const f32x4 (&AccC)[2][2][4][2];
typedef f32x4 (&AccM)[2][2][4][2];
__device__ __forceinline__ float sum16o(const unsigned char* base, unsigned off) { const f32x4 a = *(const f32x4*)(base + off), b = *(const f32x4*)(base + off + 16u), c = *(const f32x4*)(base + off + 32u), d = *(const f32x4*)(base + off + 48u);
    return ((a.x + a.y) + (a.z + a.w)) + ((b.x + b.y) + (b.z + b.w)) + ((c.x + c.y) + (c.z + c.w)) + ((d.x + d.y) + (d.z + d.w)); }
__device__ __forceinline__ float sum8o(const unsigned char* base, unsigned off) { const f32x4 a = *(const f32x4*)(base + off), b = *(const f32x4*)(base + off + 16u); return ((a.x + a.y) + (a.z + a.w)) + ((b.x + b.y) + (b.z + b.w)); }
__device__ __forceinline__ void epi_g1(AccC acc, const Unit& u, int wr, int wc, int fr, int fq, unsigned char* ws) {
    const unsigned row0 = (unsigned)(u.pm * 256 + wr * 64 + fr), colt = (unsigned)(u.pn * 256);
#pragma unroll
    for (int ai = 0; ai < 2; ++ai)
#pragma unroll
        for (int m = 0; m < 4; ++m) {
            const unsigned row = row0 + ai * 128 + m * 16;
            const float rs = rsqrtf(sum16o(ws, (unsigned)WS_SLOTS + row * 64u) * (1.0f / D) + EPS);
#pragma unroll
            for (int bj = 0; bj < 2; ++bj) {
                const unsigned c0 = colt + bj * 128 + wc * 32 + 8 * fq;
                const f32x4 v0 = acc[ai][bj][m][0] * rs, v1 = acc[ai][bj][m][1] * rs;
                u32x4 w; w.x = cvt_pk_bf16(v0[0], v0[1]); w.y = cvt_pk_bf16(v0[2], v0[3]); w.z = cvt_pk_bf16(v1[0], v1[1]); w.w = cvt_pk_bf16(v1[2], v1[3]);
                if (u.pn < 2) { const unsigned g = c0 >> 4, p0 = c0 & 15u; *(u32x4*)(ws + ((unsigned)WS_U2 + (g * (unsigned)M + row) * 32u + p0 * 2u)) = w; }
                else if (u.pn == 6 || u.pn == 7) {
                    const unsigned cv = c0 - 1536u, hh = cv >> 7, dv = cv & 127u, cid = row >> 6, s = row & 63u;
                    bf16_t* b = (bf16_t*)(ws + ((unsigned)WS_VT + (((cid * 4u + hh) * 128u + dv) * 64u + s) * 2u));
                    b[0] = (bf16_t)(w.x & 0xffffu); b[64] = (bf16_t)(w.x >> 16); b[128] = (bf16_t)(w.y & 0xffffu); b[192] = (bf16_t)(w.y >> 16);
                    b[256] = (bf16_t)(w.z & 0xffffu); b[320] = (bf16_t)(w.z >> 16); b[384] = (bf16_t)(w.w & 0xffffu); b[448] = (bf16_t)(w.w >> 16);
                } else {
                    const unsigned toff = u.pn < 4 ? (unsigned)WS_QRAW : (u.pn < 6 ? (unsigned)WS_KRAW : (unsigned)WS_ORAW), cb = c0 - (u.pn < 4 ? 512u : (u.pn < 6 ? 1024u : 2048u));
                    *(u32x4*)(ws + (toff + (row * 512u + cb) * 2u)) = w;
                }
            }
            asm volatile("" ::: "memory");
        }
}
__device__ __forceinline__ void epi_g2(AccC acc, const Unit& u, int wr, int wc, int fr, int fq, unsigned char* ws, const float* bglu) {
    const unsigned row0 = (unsigned)(u.pm * 256 + wr * 64 + fr), colt = (unsigned)(u.pn * 256);
#pragma unroll
    for (int ai = 0; ai < 2; ++ai)
#pragma unroll
        for (int m = 0; m < 4; ++m) {
            const unsigned row = row0 + ai * 128 + m * 16; float ss = 0.f;
#pragma unroll
            for (int bj = 0; bj < 2; ++bj) {
                const unsigned c0 = colt + bj * 128 + wc * 32 + 8 * fq;
                const u32x4 zv = *(const u32x4*)(ws + ((unsigned)WS_Z + (row * 512u + c0) * 2u));
                const f32x4 b0 = *(const f32x4*)((const unsigned char*)bglu + c0 * 4u), b1 = *(const f32x4*)((const unsigned char*)bglu + c0 * 4u + 16u);
                const f32x4 a0 = acc[ai][bj][m][0] + b0, a1 = acc[ai][bj][m][1] + b1;
                float zz[8];
                zz[0] = bf2f(zv.x & 0xffffu) * sigmoid_f(a0[0]); zz[1] = bf2f(zv.x >> 16) * sigmoid_f(a0[1]);
                zz[2] = bf2f(zv.y & 0xffffu) * sigmoid_f(a0[2]); zz[3] = bf2f(zv.y >> 16) * sigmoid_f(a0[3]);
                zz[4] = bf2f(zv.z & 0xffffu) * sigmoid_f(a1[0]); zz[5] = bf2f(zv.z >> 16) * sigmoid_f(a1[1]);
                zz[6] = bf2f(zv.w & 0xffffu) * sigmoid_f(a1[2]); zz[7] = bf2f(zv.w >> 16) * sigmoid_f(a1[3]);
#pragma unroll
                for (int j = 0; j < 8; ++j) ss += zz[j] * zz[j];
                u32x4 w; w.x = cvt_pk_bf16(zz[0], zz[1]); w.y = cvt_pk_bf16(zz[2], zz[3]); w.z = cvt_pk_bf16(zz[4], zz[5]); w.w = cvt_pk_bf16(zz[6], zz[7]);
                *(u32x4*)(ws + ((unsigned)WS_YCAT + (row * 1024u + c0) * 2u)) = w;
            }
            ss = sum_fq(ss);
            if (fq == 0) *(float*)(ws + ((unsigned)WS_SLOTS2 + (row * 8u + (unsigned)(u.pn * 4 + wc)) * 4u)) = ss;
            asm volatile("" ::: "memory");
        }
}
__device__ __forceinline__ void mid_g3(AccM acc, const Unit& u, int wr, int fr, unsigned char* ws) {
    const unsigned row0 = (unsigned)(u.pm * 256 + wr * 64 + fr);
#pragma unroll
    for (int ai = 0; ai < 2; ++ai)
#pragma unroll
        for (int m = 0; m < 4; ++m) {
            const unsigned row = row0 + ai * 128 + m * 16;
            const float r = rsqrtf(sum8o(ws, (unsigned)WS_SLOTS2 + row * 32u) * (1.0f / DS) + EPS);
#pragma unroll
            for (int bj = 0; bj < 2; ++bj)
#pragma unroll
                for (int n = 0; n < 2; ++n) acc[ai][bj][m][n] = acc[ai][bj][m][n] * r;
            asm volatile("" ::: "memory");
        }
}
__device__ __forceinline__ void epi_res(AccC acc, const Unit& u, int wr, int wc, int fr, int fq, unsigned char* ws, const float* xold, float* X) {
    const unsigned row0 = (unsigned)(u.pm * 256 + wr * 64 + fr), colt = (unsigned)(u.pn * 256);
#pragma unroll
    for (int ai = 0; ai < 2; ++ai)
#pragma unroll
        for (int m = 0; m < 4; ++m) {
            const unsigned row = row0 + ai * 128 + m * 16; float ss = 0.f;
            const unsigned off = row * 1024u + colt + wc * 32 + 4 * fq;
#pragma unroll
            for (int bj = 0; bj < 2; ++bj)
#pragma unroll
                for (int n = 0; n < 2; ++n) {
                    const unsigned o = off + bj * 128 + n * 16;
                    const f32x4 xn = *(const f32x4*)((const unsigned char*)xold + o * 4u) + acc[ai][bj][m][n];
                    *(f32x4*)((unsigned char*)X + o * 4u) = xn;
                    u32x2 w; w.x = cvt_pk_bf16(xn[0], xn[1]); w.y = cvt_pk_bf16(xn[2], xn[3]);
                    *(u32x2*)(ws + ((unsigned)WS_XB + o * 2u)) = w;
                    ss += (xn[0] * xn[0] + xn[1] * xn[1]) + (xn[2] * xn[2] + xn[3] * xn[3]);
                }
            ss = sum_fq(ss);
            if (fq == 0) *(float*)(ws + ((unsigned)WS_SLOTS + (row * 16u + (unsigned)(u.pn * 4 + wc)) * 4u)) = ss;
            asm volatile("" ::: "memory");
        }
}
__device__ __forceinline__ void epi_g4(AccC acc, const Unit& u, int wr, int wc, int fr, int fq, unsigned char* ws) {
    const unsigned row0 = (unsigned)(u.pm * 256 + wr * 64 + fr), colt = (unsigned)(u.pn * 256);
#pragma unroll
    for (int ai = 0; ai < 2; ++ai)
#pragma unroll
        for (int m = 0; m < 4; ++m) {
            const unsigned row = row0 + ai * 128 + m * 16;
            const float r2 = 1.0f / (sum16o(ws, (unsigned)WS_SLOTS + row * 64u) * (1.0f / D) + EPS);
#pragma unroll
            for (int bj = 0; bj < 2; ++bj) {
                const unsigned c0 = colt + bj * 128 + wc * 32 + 8 * fq;
                f32x4 v0 = acc[ai][bj][m][0], v1 = acc[ai][bj][m][1];
#pragma unroll
                for (int j = 0; j < 4; ++j) { const float a = fmaxf(v0[j], 0.f), b = fmaxf(v1[j], 0.f); v0[j] = a * a * r2; v1[j] = b * b * r2; }
                u32x4 w; w.x = cvt_pk_bf16(v0[0], v0[1]); w.y = cvt_pk_bf16(v0[2], v0[3]); w.z = cvt_pk_bf16(v1[0], v1[1]); w.w = cvt_pk_bf16(v1[2], v1[3]);
                *(u32x4*)(ws + ((unsigned)WS_H1 + (row * (unsigned)DFF + c0) * 2u)) = w;
            }
            asm volatile("" ::: "memory");
        }
}
template <int KIND> struct EpiK {
    static constexpr bool AFTER_DRAIN = false;
    unsigned char* ws; const float* aux; float* xo;
    __device__ __forceinline__ constexpr bool perm() const { return KIND == 1 || KIND == 2 || KIND == 4; }
    __device__ __forceinline__ constexpr int mid_t() const { return KIND == 3 ? 8 : -1; }
    __device__ __forceinline__ void mid(AccM acc, const Unit& u, int wr, int wc, int fr, int fq) const { if constexpr (KIND == 3) mid_g3(acc, u, wr, fr, ws); }
    __device__ __forceinline__ void operator()(AccC acc, const Unit& u, int wr, int wc, int fr, int fq) const {
        if constexpr (KIND == 1) epi_g1(acc, u, wr, wc, fr, fq, ws);
        else if constexpr (KIND == 2) epi_g2(acc, u, wr, wc, fr, fq, ws, aux);
        else if constexpr (KIND == 4) epi_g4(acc, u, wr, wc, fr, fq, ws);
        else epi_res(acc, u, wr, wc, fr, fq, ws, aux, xo);
    }
};

struct Args { const float* in[24]; float* out; unsigned char* ws; int ph_lo, ph_hi, flags, pad; };
struct Env {
    volatile LAS unsigned* pt;
    __device__ __forceinline__ unsigned long long ptr(int i) const { const unsigned lo = pt[2 * i], hi = pt[2 * i + 1];
        return ((unsigned long long)(unsigned)__builtin_amdgcn_readfirstlane((int)hi) << 32) | (unsigned)__builtin_amdgcn_readfirstlane((int)lo); }
    __device__ __forceinline__ const float* in(int i) const { return (const float*)ptr(i); }
    __device__ __forceinline__ float* out() const { return (float*)ptr(24); }
    __device__ __forceinline__ unsigned char* ws() const { return (unsigned char*)ptr(25); }
};

__device__ __forceinline__ void p0_transpose_item(const float* W, int ldw, int K, int nblk, const float* kscale, int kslen, bf16_t* WT, LAS float* scr, int item, int lane) {
    const int kb = item / nblk, nb = item % nblk, k0 = 64 * kb, n0 = 64 * nb;
    const int lr = lane >> 4, lc = (lane & 15) * 4;
    f32x4 v[16];
#pragma unroll
    for (int i = 0; i < 16; ++i) v[i] = *(const f32x4*)(W + (size_t)(k0 + 4 * i + lr) * ldw + n0 + lc);
#pragma unroll
    for (int i = 0; i < 16; ++i) { const int kk = 4 * i + lr; const float sc = (k0 + kk < kslen) ? kscale[k0 + kk] : 1.0f; LAS float* d = scr + kk * 65 + lc;
        d[0] = v[i].x * sc; d[1] = v[i].y * sc; d[2] = v[i].z * sc; d[3] = v[i].w * sc; }
    LDS_WAIT(); asm volatile("" ::: "memory");
    const int c = lane & 7;
#pragma unroll
    for (int j = 0; j < 8; ++j) { const int n = (lane >> 3) + 8 * j; const LAS float* s = scr + (8 * c) * 65 + n;
        u32x4 o; o.x = pk2(s[0 * 65], s[1 * 65]); o.y = pk2(s[2 * 65], s[3 * 65]); o.z = pk2(s[4 * 65], s[5 * 65]); o.w = pk2(s[6 * 65], s[7 * 65]);
        *(u32x4*)(WT + (size_t)(n0 + n) * K + k0 + 8 * c) = o; }
    LDS_WAIT(); asm volatile("" ::: "memory");
}
__device__ __forceinline__ void p0_weights(const Env& A, int l, LAS unsigned char* lds, int wave, int lane, int gw, int NGW) {
    unsigned char* const ws = A.ws(); const float* const i1 = A.in(1); const float* const i2 = A.in(2); const float* const i11 = A.in(11); const float* const i13 = A.in(13);
    const float* const i19 = A.in(19); const float* const i20 = A.in(20); const float* const i21 = A.in(21); const float* const i22 = A.in(22);
    LAS float* scr = (LAS float*)(lds + wave * 16640);
    constexpr int I_IN = 16 * 40, I_GLU = 8 * 8, I_OUT = 16 * 16, I_1 = 16 * 64, I_2 = 64 * 16, I_G = 16, I_L = I_IN + I_GLU + I_OUT + I_1 + I_2 + I_G;
    unsigned char* wb = ws + WS_W + (size_t)l * W_LSTRIDE;
    for (int it = gw; it < I_L; it += NGW) {
        int r = it;
        if (r < I_IN) { p0_transpose_item(i2 + (size_t)l * D * DIN, DIN, D, 40, i1 + l * D, D, (bf16_t*)(wb + OFF_WIN), scr, r, lane); continue; } r -= I_IN;
        if (r < I_GLU) { p0_transpose_item(i11 + (size_t)l * DS * DS, DS, DS, 8, nullptr, 0, (bf16_t*)(wb + OFF_WGLU), scr, r, lane); continue; } r -= I_GLU;
        if (r < I_OUT) { p0_transpose_item(i19 + (size_t)l * D * D, D, D, 16, i13 + l * DS, DS, (bf16_t*)(wb + OFF_WOUT), scr, r, lane); continue; } r -= I_OUT;
        if (r < I_1) { p0_transpose_item(i21 + (size_t)l * D * DFF, DFF, D, 64, i20 + l * D, D, (bf16_t*)(wb + OFF_W1), scr, r, lane); continue; } r -= I_1;
        if (r < I_2) { p0_transpose_item(i22 + (size_t)l * DFF * D, D, DFF, 16, nullptr, 0, (bf16_t*)(wb + OFF_W2), scr, r, lane); continue; } r -= I_2;
        { const int k = 64 * r + lane; bf16_t* wg = (bf16_t*)(wb + OFF_WG);
#pragma unroll
          for (int j = 0; j < 32; ++j) { const float v = j < 8 ? i1[l * D + k] * i2[(size_t)l * D * DIN + (size_t)k * DIN + 2560 + j] : 0.f; wg[j * 1024 + k] = (bf16_t)f2bf(v); } }
    }
}
__device__ __forceinline__ void rpass(const float* src, unsigned char* ws, int wave, int lane) {
    const int gw = blockIdx.x * NWAVES + wave, NGW = gridDim.x * NWAVES;
    bf16_t* XB = (bf16_t*)(ws + WS_XB); float* slots = (float*)(ws + WS_SLOTS);
    for (int m = gw; m < M; m += 2 * NGW) {
        const int m2 = m + NGW; const bool has2 = m2 < M;
        const f32x4* xr = (const f32x4*)(src + (size_t)m * D) + lane; const f32x4* xr2 = (const f32x4*)(src + (size_t)(has2 ? m2 : m) * D) + lane;
        f32x4 v[4], w[4]; float s = 0.f, s2 = 0.f;
#pragma unroll
        for (int j = 0; j < 4; ++j) { v[j] = xr[64 * j]; w[j] = xr2[64 * j]; }
#pragma unroll
        for (int j = 0; j < 4; ++j) { s += (v[j].x * v[j].x + v[j].y * v[j].y) + (v[j].z * v[j].z + v[j].w * v[j].w); s2 += (w[j].x * w[j].x + w[j].y * w[j].y) + (w[j].z * w[j].z + w[j].w * w[j].w); }
        s = wave_sum(s); s2 = wave_sum(s2);
        u32x2* o8 = (u32x2*)(XB + (size_t)m * D) + lane;
#pragma unroll
        for (int j = 0; j < 4; ++j) { u32x2 q; q.x = pk2(v[j].x, v[j].y); q.y = pk2(v[j].z, v[j].w); o8[64 * j] = q; }
        if (lane < 16) slots[(size_t)m * 16 + lane] = lane == 0 ? s : 0.f;
        if (has2) {
            u32x2* o9 = (u32x2*)(XB + (size_t)m2 * D) + lane;
#pragma unroll
            for (int j = 0; j < 4; ++j) { u32x2 q; q.x = pk2(w[j].x, w[j].y); q.y = pk2(w[j].z, w[j].w); o9[64 * j] = q; }
            if (lane < 16) slots[(size_t)m2 * 16 + lane] = lane == 0 ? s2 : 0.f;
        }
    }
}
__device__ __forceinline__ void build_tables(const Env& A, int l, int g, int j, LAS unsigned char* lds, int tid) {
    LAS float* pwr = (LAS float*)lds;
    LAS float* pwi = pwr + 65 * 64;
    LAS float* bbr = pwi + 65 * 64;
    LAS float* bbi = bbr + 1024;
    LAS float* cr = bbi + 1024;
    LAS float* ci = cr + 1024;
    const int lg = l * NG + g;
    unsigned char* const ws = A.ws(); const float* const i3 = A.in(3); const float* const i4 = A.in(4); const float* const i5 = A.in(5); const float* const i6 = A.in(6);
    const float* const i7 = A.in(7); const float* const i8 = A.in(8); const float* const i9 = A.in(9);
    bf16_t* KTAB = (bf16_t*)(ws + WS_KTAB) + (size_t)g * KTAB_G;
    bf16_t* WST = (bf16_t*)(ws + WS_WST) + (size_t)g * 128 * 1024;
    bf16_t* GT = (bf16_t*)(ws + WS_GT) + (size_t)g * 1024 * 128;
    float* A64 = (float*)(ws + WS_A64);
    if (tid < 64) {
        const int n = tid;
        const float are = i3[lg * NS + n], aim = i4[lg * NS + n], dt = expf(i5[lg]);
        const float mag = expf(are * dt), abr = mag * cosf(aim * dt), abi = mag * sinf(aim * dt);
        const float den = are * are + aim * aim, zr = abr - 1.0f;
        const float sr = (zr * are + abi * aim) / den, si = (abi * are - zr * aim) / den;
#pragma unroll
        for (int q = 0; q < 16; ++q) { const float br = i6[(size_t)(lg * NS + n) * 16 + q], bi = i7[(size_t)(lg * NS + n) * 16 + q];
            bbr[n * 16 + q] = sr * br - si * bi; bbi[n * 16 + q] = sr * bi + si * br; }
        double pr = 1.0, pi = 0.0; const double ar = (double)abr, ai = (double)abi;
        for (int tau = 0; tau <= 64; ++tau) { pwr[tau * 64 + n] = (float)pr; pwi[tau * 64 + n] = (float)pi; const double t = pr * ar - pi * ai; pi = pr * ai + pi * ar; pr = t; }
        if (j == 0) { A64[(g * 64 + n) * 2] = pwr[64 * 64 + n]; A64[(g * 64 + n) * 2 + 1] = pwi[64 * 64 + n]; }
    }
    for (int i = tid; i < 1024; i += NTHR) { cr[i] = i8[(size_t)lg * 1024 + i]; ci[i] = i9[(size_t)lg * 1024 + i]; }
    __syncthreads();
    for (int e = tid; e < 2048; e += NTHR) {
        const int tau = 8 * j + (e >> 8), p = (e >> 4) & 15, q = e & 15; float acc = 0.f;
        for (int n = 0; n < 64; ++n) { const float c_r = cr[p * 64 + n], c_i = ci[p * 64 + n], p_r = pwr[tau * 64 + n], p_i = pwi[tau * 64 + n];
            const float xr = c_r * p_r - c_i * p_i, xi = c_r * p_i + c_i * p_r; acc += xr * bbr[n * 16 + q] - xi * bbi[n * 16 + q]; }
        KTAB[(tau + 1) * 256 + p * 16 + q] = (bf16_t)f2bf(acc);
    }
    if (j == 0) for (int e = tid; e < 256; e += NTHR) KTAB[e] = 0;
    for (int e = tid; e < 2048; e += NTHR) {
        const int np = 16 * j + (e >> 7), oc = e & 127, n = np & 63, im = np >> 6, k0 = oc * 8, s = k0 >> 4, q0 = k0 & 15;
        const float p_r = pwr[(63 - s) * 64 + n], p_i = pwi[(63 - s) * 64 + n]; float v[8];
#pragma unroll
        for (int jj = 0; jj < 8; ++jj) { const float b_r = bbr[n * 16 + q0 + jj], b_i = bbi[n * 16 + q0 + jj]; v[jj] = im ? (p_r * b_i + p_i * b_r) : (p_r * b_r - p_i * b_i); }
        u32x4 o; o.x = pk2(v[0], v[1]); o.y = pk2(v[2], v[3]); o.z = pk2(v[4], v[5]); o.w = pk2(v[6], v[7]);
        *(u32x4*)(WST + (size_t)np * 1024 + k0) = o;
    }
    for (int e = tid; e < 2048; e += NTHR) {
        const int rl = e >> 4, oc = e & 15, t = 8 * j + (rl >> 4), p = rl & 15, np0 = oc * 8; float v[8];
#pragma unroll
        for (int jj = 0; jj < 8; ++jj) { const int np = np0 + jj, n = np & 63; const float p_r = pwr[(t + 1) * 64 + n], p_i = pwi[(t + 1) * 64 + n], c_r = cr[p * 64 + n], c_i = ci[p * 64 + n];
            v[jj] = (np >> 6) ? -(c_r * p_i + c_i * p_r) : (c_r * p_r - c_i * p_i); }
        u32x4 o; o.x = pk2(v[0], v[1]); o.y = pk2(v[2], v[3]); o.z = pk2(v[4], v[5]); o.w = pk2(v[6], v[7]);
        *(u32x4*)(GT + (size_t)(t * 16 + p) * 128 + np0) = o;
    }
    __syncthreads();
}

__device__ __forceinline__ void s5a_item(unsigned char* ws, int g, int rb, LAS unsigned char* lds, int wave, int lane) {
    const bf16_t* U2 = (const bf16_t*)(ws + WS_U2) + ((size_t)g * M + (size_t)rb * 2048) * 16;
    const bf16_t* WST = (const bf16_t*)(ws + WS_WST) + (size_t)g * 128 * 1024;
    float* XLOC = (float*)(ws + WS_XLOC);
    const int r = lane & 31, hh = lane >> 5, nt = wave & 3, kh = wave >> 2;
    f32x16 acc; for (int i = 0; i < 16; ++i) acc[i] = 0.f;
    const bf16_t* ap = U2 + (size_t)r * 1024 + kh * 512 + 8 * hh;
    const bf16_t* bp = WST + (size_t)(nt * 32 + r) * 1024 + kh * 512 + 8 * hh;
#pragma unroll 8
    for (int ks = 0; ks < 32; ++ks) { const bf16x8 a = *(const bf16x8*)(ap + ks * 16), b = *(const bf16x8*)(bp + ks * 16); acc = MFMA32(a, b, acc); }
    LAS float* part = (LAS float*)lds + nt * 1024;
    if (kh == 1) {
#pragma unroll
        for (int reg = 0; reg < 16; ++reg) part[crow(reg, hh) * 32 + r] = acc[reg];
    }
    __syncthreads();
    if (kh == 0) {
#pragma unroll
        for (int reg = 0; reg < 16; ++reg) { const int row = crow(reg, hh), cid = rb * 32 + row; XLOC[((size_t)cid * 32 + g) * 128 + nt * 32 + r] = acc[reg] + part[row * 32 + r]; }
    }
    __syncthreads();
}
__device__ __forceinline__ void mla_item(const Env& A, int l, int cid, LAS unsigned char* lds, int tid, int wave, int lane) {
    unsigned char* const ws = A.ws(); const float* const i14 = A.in(14); const float* const i15 = A.in(15); const float* const i16 = A.in(16); const float* const i17 = A.in(17);
    const bf16_t* XB = (const bf16_t*)(ws + WS_XB);
    const bf16_t* WG = (const bf16_t*)(ws + WS_W + (size_t)l * W_LSTRIDE + OFF_WG);
    const float* slots = (const float*)(ws + WS_SLOTS);
    const bf16_t* QRAW = (const bf16_t*)(ws + WS_QRAW); const bf16_t* KRAW = (const bf16_t*)(ws + WS_KRAW); const bf16_t* VT = (const bf16_t*)(ws + WS_VT);
    bf16_t* QC = (bf16_t*)(ws + WS_QC); bf16_t* KC = (bf16_t*)(ws + WS_KC); bf16_t* DC = (bf16_t*)(ws + WS_DC);
    float* BCUM = (float*)(ws + WS_BCUM); float* AARR = (float*)(ws + WS_AARR); float* PMAX = (float*)(ws + WS_PMAX);
    float* BLAST = (float*)(ws + WS_BLAST); float* MAXG = (float*)(ws + WS_MAXG); float* NLOC = (float*)(ws + WS_NLOC);
    LAS float* gpart = (LAS float*)lds;
    LAS float* garr = gpart + 4096;
    LAS float* wts = garr + 512;
    LAS bf16_t* kT = (LAS bf16_t*)(lds + 20480);
    const int row0 = cid * 64, r = lane & 31, hh = lane >> 5;
    {
        f32x16 acc0, acc1; for (int i = 0; i < 16; ++i) { acc0[i] = 0.f; acc1[i] = 0.f; }
        const bf16_t* a0 = XB + (size_t)(row0 + r) * 1024 + wave * 128 + 8 * hh;
        const bf16_t* a1 = a0 + 32 * 1024;
        const bf16_t* bp = WG + (size_t)r * 1024 + wave * 128 + 8 * hh;
#pragma unroll
        for (int ks = 0; ks < 8; ++ks) { const bf16x8 b = *(const bf16x8*)(bp + ks * 16); acc0 = MFMA32(*(const bf16x8*)(a0 + ks * 16), b, acc0); acc1 = MFMA32(*(const bf16x8*)(a1 + ks * 16), b, acc1); }
        if (r < 8) {
#pragma unroll
            for (int reg = 0; reg < 16; ++reg) { gpart[(wave * 64 + crow(reg, hh)) * 8 + r] = acc0[reg]; gpart[(wave * 64 + 32 + crow(reg, hh)) * 8 + r] = acc1[reg]; }
        }
    }
    __syncthreads();
    {   const int t = tid & 63, j = tid >> 6; float s = 0.f;
#pragma unroll
        for (int w = 0; w < 8; ++w) s += gpart[(w * 64 + t) * 8 + j];
        const float rs = rsqrtf(sum16(slots + (size_t)(row0 + t) * 16) * (1.0f / D) + EPS);
        garr[j * 64 + t] = s * rs; }
    __syncthreads();
    if (wave < 4) {
        const int h = wave, t = lane, item = cid * 4 + h;
        const float ig = garr[h * 64 + t] + i16[l * NH + h];
        const float lf = logsigmoid_f(garr[(4 + h) * 64 + t] + i17[l * NH + h]);
        float bc = lf;
#pragma unroll
        for (int o = 1; o < 64; o <<= 1) { const float v = __shfl_up(bc, o); if (lane >= o) bc += v; }
        const float a = ig - bc; float pm = a;
#pragma unroll
        for (int o = 1; o < 64; o <<= 1) { const float v = __shfl_up(pm, o); if (lane >= o) pm = fmaxf(pm, v); }
        const float amax = __shfl(pm, 63), blast = __shfl(bc, 63);
        BCUM[item * 64 + t] = bc; AARR[item * 64 + t] = a; PMAX[item * 64 + t] = pm;
        if (lane == 0) { BLAST[item] = blast; MAXG[item] = blast + amax; }
        wts[h * 64 + t] = __expf(a - amax);
    }
    __syncthreads();
    const float* cw = i14 + l * 4 * 1024; const float* cb = i15 + l * 1024;
    const float kscale = 0.08838834764831845f;
    for (int h = 0; h < NH; ++h) {
        const int item = cid * 4 + h;
        {
            const int ch2 = tid & 63, rg = tid >> 6, c = h * DH + 2 * ch2;
            float wq0[4], wq1[4], wk0[4], wk1[4];
#pragma unroll
            for (int jj = 0; jj < 4; ++jj) { wq0[jj] = cw[jj * 1024 + c]; wq1[jj] = cw[jj * 1024 + c + 1]; wk0[jj] = cw[jj * 1024 + 512 + c]; wk1[jj] = cw[jj * 1024 + 512 + c + 1]; }
            const float bq0 = cb[c], bq1 = cb[c + 1], bk0 = cb[512 + c], bk1 = cb[512 + c + 1];
            float rq0[11], rq1[11], rk0[11], rk1[11];
#pragma unroll
            for (int i = 0; i < 11; ++i) {
                const int tl = rg * 8 - 3 + i; const bool valid = (tl >= 0) || ((cid & (CPB - 1)) != 0);
                unsigned uq = 0u, uk = 0u;
                if (valid) { uq = *(const unsigned*)(QRAW + (size_t)(row0 + tl) * 512 + c); uk = *(const unsigned*)(KRAW + (size_t)(row0 + tl) * 512 + c); }
                rq0[i] = bf2f(uq & 0xffffu); rq1[i] = bf2f(uq >> 16); rk0[i] = bf2f(uk & 0xffffu); rk1[i] = bf2f(uk >> 16);
            }
#pragma unroll
            for (int i = 0; i < 8; ++i) {
                const int t = rg * 8 + i;
                float aq0 = bq0, aq1 = bq1, ak0 = bk0, ak1 = bk1;
#pragma unroll
                for (int jj = 0; jj < 4; ++jj) { aq0 += wq0[jj] * rq0[i + jj]; aq1 += wq1[jj] * rq1[i + jj]; ak0 += wk0[jj] * rk0[i + jj]; ak1 += wk1[jj] * rk1[i + jj]; }
                const float q0 = aq0 * sigmoid_f(aq0), q1 = aq1 * sigmoid_f(aq1), k0 = ak0 * sigmoid_f(ak0) * kscale, k1 = ak1 * sigmoid_f(ak1) * kscale;
                *(unsigned*)(QC + (size_t)(row0 + t) * 512 + c) = pk2(q0, q1);
                const unsigned kb = pk2(k0, k1);
                *(unsigned*)(KC + (size_t)(row0 + t) * 512 + c) = kb;
                const float wt = wts[h * 64 + t];
                kT[(2 * ch2) * 72 + t] = (bf16_t)f2bf(wt * bf2f(kb & 0xffffu)); kT[(2 * ch2 + 1) * 72 + t] = (bf16_t)f2bf(wt * bf2f(kb >> 16));
            }
        }
        __syncthreads();
        {
            const int mt = wave >> 1, ntp = (wave & 1) * 2;
            f32x16 c0, c1; for (int i = 0; i < 16; ++i) { c0[i] = 0.f; c1[i] = 0.f; }
            const bf16_t* ap = VT + ((size_t)item * 128 + mt * 32 + r) * 64 + 8 * hh;
#pragma unroll
            for (int ks = 0; ks < 4; ++ks) {
                const bf16x8 a = *(const bf16x8*)(ap + ks * 16);
                const bf16x8 b0 = *(const LAS bf16x8*)(kT + (ntp * 32 + r) * 72 + ks * 16 + 8 * hh), b1 = *(const LAS bf16x8*)(kT + ((ntp + 1) * 32 + r) * 72 + ks * 16 + 8 * hh);
                c0 = MFMA32(a, b0, c0); c1 = MFMA32(a, b1, c1);
            }
            bf16_t* dc = DC + (size_t)item * 16384;
#pragma unroll
            for (int reg = 0; reg < 16; ++reg) { const int dv = mt * 32 + crow(reg, hh); dc[dv * 128 + ntp * 32 + r] = (bf16_t)f2bf(c0[reg]); dc[dv * 128 + (ntp + 1) * 32 + r] = (bf16_t)f2bf(c1[reg]); }
            if (tid < DH) { float s = 0.f; for (int t = 0; t < 64; ++t) s += bf2f(kT[tid * 72 + t]); NLOC[(size_t)item * DH + tid] = s; }
        }
        __syncthreads();
    }
}

__device__ __forceinline__ void m2_scans(const Env& A, int l, LAS unsigned char* lds, int tid, int wave, int lane) {
    unsigned char* const ws = A.ws();
    const float* BLAST = (const float*)(ws + WS_BLAST); const float* MAXG = (const float*)(ws + WS_MAXG); float* MST = (float*)(ws + WS_MST);
    const int nb = gridDim.x, nbC = nb >= 2 ? nb / 2 : 1, bid = blockIdx.x;
    if (bid < nbC || nb < 2) {
        const bf16_t* DC = (const bf16_t*)(ws + WS_DC); bf16_t* CST = (bf16_t*)(ws + WS_CST);
        constexpr int NPAIR = NH * 2 * DH * DH / 2;
        for (int it = bid * NTHR + tid; it < NPAIR; it += nbC * NTHR) {
            const int bh = it >> 13, idx = (it & 8191) * 2, b = bh >> 2, h = bh & 3;
            float C0 = 0.f, C1 = 0.f, mp = 0.f;
            for (int c0 = 0; c0 < CPB; c0 += 16) {
                unsigned v[16]; float bl[16], mg[16];
#pragma unroll
                for (int u = 0; u < 16; ++u) { const int item = (b * CPB + c0 + u) * 4 + h; v[u] = *(const unsigned*)(DC + (size_t)item * 16384 + idx); bl[u] = BLAST[item]; mg[u] = MAXG[item]; }
#pragma unroll
                for (int u = 0; u < 16; ++u) {
                    const int item = (b * CPB + c0 + u) * 4 + h;
                    *(unsigned*)(CST + (size_t)item * CSTR + idx) = pk2(C0, C1);
                    if (idx == 0) MST[item] = mp;
                    const float mn = fmaxf(bl[u] + mp, mg[u]);
                    const float d1 = __expf(bl[u] + mp - mn), d2 = __expf(mg[u] - mn);
                    C0 = d1 * C0 + d2 * bf2f(v[u] & 0xffffu); C1 = d1 * C1 + d2 * bf2f(v[u] >> 16); mp = mn;
                }
            }
        }
    }
    if (bid >= nbC || nb < 2) {
        const int ob = nb < 2 ? 0 : bid - nbC, nob = nb < 2 ? 1 : nb - nbC;
        const float* NLOC = (const float*)(ws + WS_NLOC); bf16_t* CST = (bf16_t*)(ws + WS_CST);
        const float* XLOC = (const float*)(ws + WS_XLOC); bf16_t* XPREV = (bf16_t*)(ws + WS_XPREV); const float* A64 = (const float*)(ws + WS_A64);
        constexpr int NN = NH * 2 * DH, NX = 2 * NG * NS;
        for (int it = ob * NTHR + tid; it < NN + NX; it += nob * NTHR) {
            if (it < NN) {
                const int bh = it >> 7, idx = it & 127, b = bh >> 2, h = bh & 3;
                float Cp = 0.f, mp = 0.f;
                for (int c0 = 0; c0 < CPB; c0 += 16) {
                    float v[16], bl[16], mg[16];
#pragma unroll
                    for (int u = 0; u < 16; ++u) { const int item = (b * CPB + c0 + u) * 4 + h; v[u] = NLOC[(size_t)item * DH + idx]; bl[u] = BLAST[item]; mg[u] = MAXG[item]; }
#pragma unroll
                    for (int u = 0; u < 16; ++u) {
                        const int item = (b * CPB + c0 + u) * 4 + h;
                        CST[(size_t)item * CSTR + 16384 + idx] = (bf16_t)f2bf(Cp);
                        const float mn = fmaxf(bl[u] + mp, mg[u]);
                        Cp = __expf(bl[u] + mp - mn) * Cp + __expf(mg[u] - mn) * v[u]; mp = mn;
                    }
                }
            } else {
                const int e = it - NN, b = e >> 11, g = (e >> 6) & 31, n = e & 63;
                const float ar = A64[(g * 64 + n) * 2], ai = A64[(g * 64 + n) * 2 + 1]; float xr = 0.f, xi = 0.f;
                for (int c0 = 0; c0 < CPB; c0 += 16) {
                    float lr[16], li[16];
#pragma unroll
                    for (int u = 0; u < 16; ++u) { const size_t base = ((size_t)(b * CPB + c0 + u) * 32 + g) * 128; lr[u] = XLOC[base + n]; li[u] = XLOC[base + 64 + n]; }
#pragma unroll
                    for (int u = 0; u < 16; ++u) { const size_t base = ((size_t)(b * CPB + c0 + u) * 32 + g) * 128;
                        XPREV[base + n] = (bf16_t)f2bf(xr); XPREV[base + 64 + n] = (bf16_t)f2bf(xi);
                        const float nr = ar * xr - ai * xi + lr[u], ni = ar * xi + ai * xr + li[u]; xr = nr; xi = ni; }
                }
            }
        }
        if (l == 0) {
            const int nscan = (NN + NX + NTHR - 1) / NTHR;
            if (nob > nscan && ob >= nscan) p0_weights(A, 1, lds, wave, lane, (ob - nscan) * NWAVES + wave, (nob - nscan) * NWAVES);
            else if (nob <= nscan) p0_weights(A, 1, lds, wave, lane, ob * NWAVES + wave, nob * NWAVES);
        }
    }
}

constexpr int USTR = 2048 + 16, S5C_KT = 32 * USTR, S5C_XP = S5C_KT + 65 * 512, XPSTR = 256 + 16;
static_assert(S5C_XP + 32 * XPSTR <= RING_BYTES, "S5c LDS");
__device__ __forceinline__ void s5c_item(const Env& A, int l, int g, int rb, LAS unsigned char* lds, int tid, int wave, int lane) {
    unsigned char* const ws = A.ws(); const float* const i10 = A.in(10);
    const unsigned char* U2b = (const unsigned char*)((const bf16_t*)(ws + WS_U2) + ((size_t)g * M + (size_t)rb * 2048) * 16);
    const unsigned char* KTb = (const unsigned char*)((const bf16_t*)(ws + WS_KTAB) + (size_t)g * KTAB_G);
    const bf16_t* XPREV = (const bf16_t*)(ws + WS_XPREV);
    const bf16_t* GT = (const bf16_t*)(ws + WS_GT) + (size_t)g * 1024 * 128;
    bf16_t* Z = (bf16_t*)(ws + WS_Z);
    for (int i = tid; i < 4096; i += NTHR) { const int rr = i >> 7, c = i & 127; *(LAS u32x4*)(lds + rr * USTR + c * 16) = *(const u32x4*)(U2b + (size_t)i * 16); }
    for (int i = tid; i < 2080; i += NTHR) *(LAS u32x4*)(lds + S5C_KT + i * 16) = *(const u32x4*)(KTb + (size_t)i * 16);
    { const int rr = tid >> 4, c = tid & 15; *(LAS u32x4*)(lds + S5C_XP + rr * XPSTR + c * 16) = *(const u32x4*)(XPREV + ((size_t)(rb * 32 + rr) * 32 + g) * 128 + c * 8); }
    __syncthreads();
    const int r = lane & 31, hh = lane >> 5, tsub = r >> 4, p = r & 15;
    int tt[4]; tt[0] = wave; tt[1] = 15 - wave; tt[2] = 16 + wave; tt[3] = 31 - wave;
    f32x16 acc[4];
#pragma unroll
    for (int j = 0; j < 4; ++j) for (int i = 0; i < 16; ++i) acc[j][i] = 0.f;
    const LAS unsigned char* ua = lds + r * USTR + hh * 16;
    const LAS unsigned char* kb = lds + S5C_KT + p * 32 + hh * 16;
#pragma unroll 2
    for (int s = 0; s < 64; ++s) {
        const bf16x8 a = *(const LAS bf16x8*)(ua + s * 32);
#pragma unroll
        for (int j = 0; j < 4; ++j) if (s <= 2 * tt[j] + 1) { const int tau1 = 2 * tt[j] + tsub - s + 1; const bf16x8 b = *(const LAS bf16x8*)(kb + tau1 * 512); acc[j] = MFMA32(a, b, acc[j]); }
    }
    const LAS unsigned char* xa = lds + S5C_XP + r * XPSTR + hh * 16;
#pragma unroll
    for (int ks = 0; ks < 8; ++ks) {
        const bf16x8 a = *(const LAS bf16x8*)(xa + ks * 32);
#pragma unroll
        for (int j = 0; j < 4; ++j) { const bf16x8 b = *(const bf16x8*)(GT + (size_t)(tt[j] * 32 + r) * 128 + ks * 16 + 8 * hh); acc[j] = MFMA32(a, b, acc[j]); }
    }
    const float dd = i10[(l * NG + g) * 16 + p];
#pragma unroll
    for (int j = 0; j < 4; ++j) {
        const int t = 2 * tt[j] + tsub;
#pragma unroll
        for (int reg = 0; reg < 16; ++reg) {
            const int row = crow(reg, hh);
            const float uv = bf2f(*(const LAS bf16_t*)(lds + row * USTR + (t * 16 + p) * 2));
            const float y = acc[j][reg] + dd * uv;
            Z[((size_t)(rb * 32 + row) * 64 + t) * 512 + g * 16 + p] = (bf16_t)f2bf(gelu_tanh(y));
        }
    }
    __syncthreads();
}
constexpr int PSTR = 72;
__device__ __forceinline__ void mlc_item(const Env& A, int l, int item, LAS unsigned char* lds, int tid, int wave, int lane) {
    unsigned char* const ws = A.ws(); const float* const i18 = A.in(18);
    const int cid = item >> 2, h = item & 3, row0 = cid * 64, r = lane & 31, hh = lane >> 5;
    const bf16_t* QC = (const bf16_t*)(ws + WS_QC) + (size_t)row0 * 512 + h * DH;
    const bf16_t* KC = (const bf16_t*)(ws + WS_KC) + (size_t)row0 * 512 + h * DH;
    const bf16_t* VT = (const bf16_t*)(ws + WS_VT) + (size_t)item * 128 * 64;
    const bf16_t* CST = (const bf16_t*)(ws + WS_CST) + (size_t)item * CSTR;
    const bf16_t* ORAW = (const bf16_t*)(ws + WS_ORAW) + (size_t)row0 * 512 + h * DH;
    bf16_t* YCAT = (bf16_t*)(ws + WS_YCAT) + (size_t)row0 * 1024 + 512 + h * DH;
    LAS float* sc = (LAS float*)lds;
    LAS float* emt = sc + 64;
    LAS float* Mtl = emt + 64;
    LAS float* al = Mtl + 64;
    LAS float* den2 = al + 64;
    LAS float* rsum = den2 + 64;
    LAS float* hsq = rsum + 128;
    LAS bf16_t* P = (LAS bf16_t*)(lds + 4096);
    if (tid < 64) {
        const int t = tid; const float bc = ((const float*)(ws + WS_BCUM))[item * 64 + t], a = ((const float*)(ws + WS_AARR))[item * 64 + t], pm = ((const float*)(ws + WS_PMAX))[item * 64 + t];
        const float mst = ((const float*)(ws + WS_MST))[item];
        const float Mt = fmaxf(mst, pm);
        sc[t] = __expf(mst - Mt); emt[t] = __expf(-bc - Mt); Mtl[t] = Mt; al[t] = a; rsum[64 + t] = 0.f;
    }
    __syncthreads();
    const int mt = wave >> 2, nt = wave & 3;
    f32x16 accQ, accN; for (int i = 0; i < 16; ++i) { accQ[i] = 0.f; accN[i] = 0.f; }
    {
        const bf16_t* ap = QC + (size_t)(mt * 32 + r) * 512 + 8 * hh;
        const bf16_t* bp = CST + (size_t)(nt * 32 + r) * 128 + 8 * hh;
        const bf16_t* bn = CST + (size_t)(128 + r) * 128 + 8 * hh;
#pragma unroll
        for (int ks = 0; ks < 8; ++ks) {
            const bf16x8 a = *(const bf16x8*)(ap + ks * 16), b = *(const bf16x8*)(bp + ks * 16);
            accQ = MFMA32(a, b, accQ);
            if (nt == 0) { const bf16x8 b2 = *(const bf16x8*)(bn + ks * 16); accN = MFMA32(a, b2, accN); }
        }
        if (nt == 0 && r == 0) {
#pragma unroll
            for (int reg = 0; reg < 16; ++reg) den2[mt * 32 + crow(reg, hh)] = accN[reg];
        }
#pragma unroll
        for (int reg = 0; reg < 16; ++reg) accQ[reg] *= sc[mt * 32 + crow(reg, hh)];
    }
    if (wave < 3) {
        const int st = wave == 2 ? 1 : 0, tq = wave == 0 ? 0 : 1;
        f32x16 accS; for (int i = 0; i < 16; ++i) accS[i] = 0.f;
        const bf16_t* ap = KC + (size_t)(st * 32 + r) * 512 + 8 * hh;
        const bf16_t* bp = QC + (size_t)(tq * 32 + r) * 512 + 8 * hh;
#pragma unroll
        for (int ks = 0; ks < 8; ++ks) { const bf16x8 a = *(const bf16x8*)(ap + ks * 16), b = *(const bf16x8*)(bp + ks * 16); accS = MFMA32(a, b, accS); }
        const int t = tq * 32 + r; const float Mt = Mtl[t]; float rs = 0.f;
#pragma unroll
        for (int reg = 0; reg < 16; ++reg) {
            const int s = st * 32 + crow(reg, hh);
            const float w = (s <= t) ? __expf(al[s] - Mt) : 0.f;
            const float pv = accS[reg] * w; rs += pv;
            P[t * PSTR + s] = (bf16_t)f2bf(pv);
        }
        rs += __shfl_xor(rs, 32);
        if (hh == 0) rsum[st * 64 + t] = rs;
    }
    __syncthreads();
    {
        const LAS bf16_t* pa = P + (mt * 32 + r) * PSTR + 8 * hh;
        const bf16_t* bp = VT + (size_t)(nt * 32 + r) * 64 + 8 * hh;
        const int nks = 2 * (mt + 1);
        for (int ks = 0; ks < nks; ++ks) { const bf16x8 a = *(const LAS bf16x8*)(pa + ks * 16), b = *(const bf16x8*)(bp + ks * 16); accQ = MFMA32(a, b, accQ); }
    }
    const int dv = nt * 32 + r;
#pragma unroll
    for (int reg = 0; reg < 16; ++reg) {
        const int t = mt * 32 + crow(reg, hh);
        const float den = rsum[t] + rsum[64 + t] + sc[t] * den2[t];
        const float hv = accQ[reg] / fmaxf(fabsf(den), emt[t]);
        const float o = sigmoid_f(bf2f(ORAW[(size_t)t * 512 + dv]));
        const float ho = o * hv; accQ[reg] = ho;
        float sq = ho * ho;
        sq += __shfl_xor(sq, 1); sq += __shfl_xor(sq, 2); sq += __shfl_xor(sq, 4); sq += __shfl_xor(sq, 8); sq += __shfl_xor(sq, 16);
        if (r == 0) hsq[nt * 64 + t] = sq;
    }
    __syncthreads();
    const float gg = i18[l * 512 + h * DH + dv];
#pragma unroll
    for (int reg = 0; reg < 16; ++reg) {
        const int t = mt * 32 + crow(reg, hh);
        const float rsn = rsqrtf(((hsq[t] + hsq[64 + t]) + (hsq[128 + t] + hsq[192 + t])) * (1.0f / DH) + EPS);
        YCAT[(size_t)t * 1024 + dv] = (bf16_t)f2bf(accQ[reg] * rsn * gg);
    }
    __syncthreads();
}
__device__ __forceinline__ void final_norm(const Env& A, int wave, int lane) {
    const int gw = blockIdx.x * NWAVES + wave, NGW = gridDim.x * NWAVES;
    const float* slots = (const float*)(A.ws() + WS_SLOTS); const f32x4* gv = (const f32x4*)A.in(23) + lane; float* const xo = A.out();
    for (int m = gw; m < M; m += NGW) {
        f32x4* xr = (f32x4*)(xo + (size_t)m * D) + lane;
        const float rs = rsqrtf(sum16(slots + (size_t)m * 16) * (1.0f / D) + EPS);
#pragma unroll
        for (int j = 0; j < 4; ++j) { const f32x4 v = xr[64 * j]; xr[64 * j] = v * rs * gv[64 * j]; }
    }
}

constexpr int N_PHASES = 18;
#ifndef MK_PHMASK
#define MK_PHMASK 0x3ff
#endif
#define PHEN(i) (((MK_PHMASK) >> (i)) & 1)
__global__ void __launch_bounds__(NTHR, 2) mega_fwd(Args args) {
    extern __shared__ __attribute__((aligned(16))) unsigned char lds_raw[];
    LAS unsigned char* lds = (LAS unsigned char*)lds_raw;
    volatile LAS unsigned* MISC = (volatile LAS unsigned*)(lds + MISC_OFF);
    volatile LAS unsigned* PT = (volatile LAS unsigned*)(lds + MISC_OFF - 256);
    if (threadIdx.x < 64) MISC[threadIdx.x] = 0u;
    if (threadIdx.x == 0) {
#pragma unroll
        for (int i = 0; i < 24; ++i) { const unsigned long long v = (unsigned long long)args.in[i]; PT[2 * i] = (unsigned)v; PT[2 * i + 1] = (unsigned)(v >> 32); }
        { const unsigned long long v = (unsigned long long)args.out; PT[48] = (unsigned)v; PT[49] = (unsigned)(v >> 32); }
        { const unsigned long long v = (unsigned long long)args.ws; PT[50] = (unsigned)v; PT[51] = (unsigned)(v >> 32); }
    }
    __syncthreads();
    Env A; A.pt = PT;
    const int wave0 = __builtin_amdgcn_readfirstlane(threadIdx.x >> 6);
    XcdBarrier bar = xcd_barrier_post((unsigned*)(args.ws + WS_CTL) + CW_BAR, MISC + 8);
    const int lo = args.ph_lo, hi = args.ph_hi, flags = args.flags;
#ifndef MK_REP_PH
#define MK_REP_PH -1
#endif
    for (int ph = lo, rep = 0; ph < hi; (ph == MK_REP_PH && rep == 0) ? (rep = 1) : (rep = 0, ++ph)) {
        int wave = wave0; asm volatile("" : "+s"(wave));
        int lane; asm volatile("v_mbcnt_lo_u32_b32 %0, -1, 0\n\tv_mbcnt_hi_u32_b32 %0, -1, %0" : "=v"(lane));
        __builtin_assume(lane >= 0 && lane < 64); __builtin_assume(wave >= 0 && wave < 8);
        const int tid = wave * 64 + lane;
        if (ph > lo || rep) xcd_barrier(bar, (unsigned*)(A.ws() + WS_CTL) + CW_BAR, tid == 0);
        if (ph == 0) { if (PHEN(0)) {
            p0_weights(A, 0, lds, wave, lane, blockIdx.x * NWAVES + wave, gridDim.x * NWAVES);
            rpass(A.in(0), A.ws(), wave, lane);
            __syncthreads();
            for (int it = blockIdx.x; it < 256; it += gridDim.x) build_tables(A, 0, it >> 3, it & 7, lds, tid); }
        } else if (ph == 17) {
            if (PHEN(9)) final_norm(A, wave, lane);
        } else {
            const int l = (ph - 1) >> 3, k = (ph - 1) & 7;
            unsigned char* const ws = A.ws();
            if (k == 1) { if (PHEN(2)) {
                for (int it = blockIdx.x; it < 256; it += gridDim.x) s5a_item(ws, it & 31, it >> 5, lds, wave, lane);
                for (int it = blockIdx.x; it < NCHUNK; it += gridDim.x) mla_item(A, l, it, lds, tid, wave, lane); }
            } else if (k == 2) {
                if (PHEN(3)) m2_scans(A, l, lds, tid, wave, lane);
            } else if (k == 3) { if (PHEN(4)) {
                for (int it = blockIdx.x; it < 256; it += gridDim.x) s5c_item(A, l, it & 31, it >> 5, lds, tid, wave, lane);
                for (int it = blockIdx.x; it < NITEM; it += gridDim.x) mlc_item(A, l, it, lds, tid, wave, lane); }
            } else {
#define LAUNDER_TD() int wv = wave0; asm volatile("" : "+s"(wv)); int ln; asm volatile("v_mbcnt_lo_u32_b32 %0, -1, 0\n\tv_mbcnt_hi_u32_b32 %0, -1, %0" : "=v"(ln)); __builtin_assume(ln >= 0 && ln < 64); __builtin_assume(wv >= 0 && wv < 8); const int td = wv * 64 + ln
                unsigned char* const wb = ws + WS_W + (size_t)l * W_LSTRIDE;
                if (k == 0) { if (PHEN(1)) {
                    if ((flags & 1) && ph == lo && l == 1) { rpass(A.out(), ws, wave, lane); xcd_barrier(bar, (unsigned*)(ws + WS_CTL) + CW_BAR, tid == 0); }
                    pg8::Gemm g{(const bf16_t*)(ws + WS_XB), (const bf16_t*)(wb + OFF_WIN), M, NP, D}; pg8::StaticOrder S; S.init(M, NP, gridDim.x, blockIdx.x);
                    EpiK<1> E{ws, nullptr, nullptr}; LAUNDER_TD();
                    pg8::gemm_phase<EpiK<1>, pg8::StaticOrder, true, true>(lds, g, S, E, td); }
                } else if (k == 4) { if (PHEN(5)) {
                    pg8::Gemm g{(const bf16_t*)(ws + WS_Z), (const bf16_t*)(wb + OFF_WGLU), M, DS, DS}; pg8::StaticOrder S; S.init(M, DS, gridDim.x, blockIdx.x);
                    EpiK<2> E{ws, A.in(12) + l * DS, nullptr}; LAUNDER_TD();
                    pg8::gemm_phase<EpiK<2>, pg8::StaticOrder, true, true>(lds, g, S, E, td);
                    if (l == 0) {
                        __syncthreads();
                        const int nfree = (int)gridDim.x > 128 ? (int)gridDim.x - 128 : (int)gridDim.x, first = (int)gridDim.x > 128 ? 128 : 0;
                        if ((int)blockIdx.x >= first) for (int it = blockIdx.x - first; it < 256; it += nfree) build_tables(A, 1, it >> 3, it & 7, lds, tid);
                    } }
                } else if (k == 5) { if (PHEN(6)) {
                    pg8::Gemm g{(const bf16_t*)(ws + WS_YCAT), (const bf16_t*)(wb + OFF_WOUT), M, D, D}; pg8::StaticOrder S; S.init(M, D, gridDim.x, blockIdx.x);
                    float* const xo = A.out();
                    EpiK<3> E{ws, l == 0 ? A.in(0) : (const float*)xo, xo}; LAUNDER_TD();
                    pg8::gemm_phase<EpiK<3>, pg8::StaticOrder, true, true>(lds, g, S, E, td); }
                } else if (k == 6) { if (PHEN(7)) {
                    pg8::Gemm g{(const bf16_t*)(ws + WS_XB), (const bf16_t*)(wb + OFF_W1), M, DFF, D}; pg8::StaticOrder S; S.init(M, DFF, gridDim.x, blockIdx.x);
                    EpiK<4> E{ws, nullptr, nullptr}; LAUNDER_TD();
                    pg8::gemm_phase<EpiK<4>, pg8::StaticOrder, true, true>(lds, g, S, E, td); }
                } else { if (PHEN(8)) {
                    pg8::Gemm g{(const bf16_t*)(ws + WS_H1), (const bf16_t*)(wb + OFF_W2), M, D, DFF}; pg8::StaticOrder S; S.init(M, D, gridDim.x, blockIdx.x);
                    float* const xo = A.out();
                    EpiK<5> E{ws, xo, xo}; LAUNDER_TD();
                    pg8::gemm_phase<EpiK<5>, pg8::StaticOrder, true, true>(lds, g, S, E, td); }
                }
            }
        }
    }
}

extern "C" void kernel_launch(void* const* d_in, const int* in_sizes, int n_in, void* d_out, int out_size, void* d_ws, size_t ws_size, hipStream_t stream) {
    static int grid = 0;
    if (grid == 0) {
        if (n_in != 24 || out_size != M * D || ws_size < WS_END) { fprintf(stderr, "kernel_launch: unexpected problem shape (n_in %d out %d ws %zu)\n", n_in, out_size, ws_size); grid = -1; return; }
        int dev = 0, cus = 0, per_cu = 0;
        if (hipGetDevice(&dev) != hipSuccess || hipDeviceGetAttribute(&cus, hipDeviceAttributeMultiprocessorCount, dev) != hipSuccess) { grid = -1; return; }
        if (hipFuncSetAttribute((const void*)mega_fwd, hipFuncAttributeMaxDynamicSharedMemorySize, LDS_BYTES) != hipSuccess) { fprintf(stderr, "kernel_launch: hipFuncSetAttribute failed\n"); grid = -1; return; }
        if (hipOccupancyMaxActiveBlocksPerMultiprocessor(&per_cu, (const void*)mega_fwd, NTHR, LDS_BYTES) != hipSuccess || per_cu < 1) { fprintf(stderr, "kernel_launch: occupancy query says %d\n", per_cu); per_cu = 1; }
        (void)hipGetLastError();
        grid = cus;
    }
    if (grid < 0) return;
    (void)hipMemsetAsync((char*)d_ws + WS_CTL, 0, CTL_ZERO_BYTES, stream);
    Args a{};
    for (int i = 0; i < 24; ++i) a.in[i] = (const float*)d_in[i];
    a.out = (float*)d_out; a.ws = (unsigned char*)d_ws; a.flags = 0; a.pad = 0;
#ifndef MK_SPLIT
    a.ph_lo = 0; a.ph_hi = N_PHASES;
    hipLaunchKernelGGL(mega_fwd, dim3(grid), dim3(NTHR), LDS_BYTES, stream, a);
#else
    for (int ph = 0; ph < N_PHASES; ++ph) { a.ph_lo = ph; a.ph_hi = ph + 1; hipLaunchKernelGGL(mega_fwd, dim3(grid), dim3(NTHR), LDS_BYTES, stream, a); }
#endif
}
```

```cpp
#include <hip/hip_runtime.h>
#include <cstdio>
#include <cstdint>
namespace pg8 {
#define PG8_LAS __attribute__((address_space(3)))
typedef unsigned short bf16_t;
typedef short bf16x8 __attribute__((ext_vector_type(8)));
typedef float f32x4 __attribute__((ext_vector_type(4)));
typedef unsigned u32x4 __attribute__((ext_vector_type(4)));
constexpr int BM = 256, BK = 64, HALF = 128, HTB = HALF * BK * 2  , STAGE_BYTES = 8 * HTB, NXCD = 8, WGM = 8;

__host__ __device__ __forceinline__ int lds_byte(int r, int c) { const int st = (r >> 4) * 2 + (c >> 5), rr = r & 15, cc = c & 31, ob = rr * 64 + cc * 2; return st * 1024 + (ob ^ (((ob >> 9) & 1) << 5)); }
__host__ __device__ __forceinline__ void stage_rc(int b, int& R, int& C) { const int st = b / 1024, sb = b % 1024, swz = sb ^ (((sb >> 9) & 1) << 5); R = (st >> 1) * 16 + swz / 64; C = (st & 1) * 32 + (swz % 64) / 2; }
__host__ __device__ __forceinline__ int perm32(int rho) { const int n = rho >> 4, i = rho & 15; return 8 * (i >> 2) + 4 * n + (i & 3); }

struct Unit { int pm, pn; };
struct Gemm { const bf16_t* A; const bf16_t* Bt; int M, N, K; };

struct StaticOrder {
    int nM, nN, nwg, G, c;
    __host__ __device__ void init(int M, int N, int G_, int c_) { nM = M / BM; nN = N / BM; nwg = nM * nN; G = G_; c = c_; }
    __host__ __device__ bool next(int i, Unit& u) const {
        const long L = (long)i * G + c; if (L >= nwg) return false;
        int wgid = (int)L; { const int q = nwg / NXCD, r = nwg % NXCD, xcd = wgid % NXCD, off = wgid / NXCD; wgid = (xcd < r ? xcd * (q + 1) : r * (q + 1) + (xcd - r) * q) + off; }
        const int nig = WGM * nN, gid = wgid / nig, fm = gid * WGM, gsz = (nM - fm) < WGM ? (nM - fm) : WGM;
        u.pm = fm + ((wgid % nig) % gsz); u.pn = (wgid % nig) / gsz; return true;
    }
    __device__ __forceinline__ void a_ready(const Unit&) const {}
    __device__ __forceinline__ void done(const Unit&) const {}
};
__device__ __forceinline__ unsigned cvt_pk_bf16(float lo, float hi) { unsigned r; asm volatile("v_cvt_pk_bf16_f32 %0, %1, %2" : "=v"(r) : "v"(lo), "v"(hi)); return r; }

template <class Epi, class Sched, bool ALIGN_EPI = false, bool SP2 = false>
__device__ __forceinline__ void gemm_phase(PG8_LAS unsigned char* lds, const Gemm g, const Sched& S, const Epi& E, const int tid) {
    const int wid = __builtin_amdgcn_readfirstlane(tid >> 6), lane = tid & 63, wr = wid >> 2, wc = wid & 3, fr = lane & 15, fq = lane >> 4;
    const int K = g.K, nt = K / BK;
    unsigned voffA[2], voffB[2];
#pragma unroll
    for (int i = 0; i < 2; ++i) { int R, C; stage_rc(tid * 16 + i * 8192, R, C); const int Rb = E.perm() ? ((R & ~31) + perm32(R & 31)) : R;
        voffA[i] = (unsigned)(R * K + C) * 2u; voffB[i] = (unsigned)(Rb * K + C) * 2u; }
    const size_t kstep = (size_t)(BK * 2);
    const size_t hstep = (size_t)HALF * K * 2;
    const size_t tstep = 2 * hstep;
    const unsigned ldsw = (unsigned)wid * 1024u;
    const int aoff = lds_byte(wr * 64 + fr, fq * 8), boff = lds_byte(wc * 32 + fr, fq * 8);
#define PG8_SA(b, h) (((b) * 2 + (h)) * HTB)
#define PG8_SB(b, h) ((4 + (b) * 2 + (h)) * HTB)
#define PG8_STAGE(bufoff, gbase, voff) do { _Pragma("unroll") for (int _i = 0; _i < 2; ++_i) \
        __builtin_amdgcn_global_load_lds((const unsigned*)((const char*)(gbase) + (voff)[_i]), (PG8_LAS unsigned*)(lds + (bufoff) + ldsw + _i * 8192), 16, 0, 0); } while (0)
#define PG8_LDA(dst, b, h) do { _Pragma("unroll") for (int m = 0; m < 4; ++m) _Pragma("unroll") for (int k = 0; k < 2; ++k) dst[m][k] = *(const PG8_LAS bf16x8*)(lds + PG8_SA(b, h) + aoff + m * 2048 + k * 1024); } while (0)
#define PG8_LDB(dst, b, h) do { _Pragma("unroll") for (int n = 0; n < 2; ++n) _Pragma("unroll") for (int k = 0; k < 2; ++k) dst[n][k] = *(const PG8_LAS bf16x8*)(lds + PG8_SB(b, h) + boff + n * 2048 + k * 1024); } while (0)
#define PG8_MMA(ai, bj, At, Bt) do { __builtin_amdgcn_s_setprio(1); _Pragma("unroll") for (int m = 0; m < 4; ++m) _Pragma("unroll") for (int n = 0; n < 2; ++n) _Pragma("unroll") for (int k = 0; k < 2; ++k) \
        acc[ai][bj][m][n] = __builtin_amdgcn_mfma_f32_16x16x32_bf16(Bt[n][k], At[m][k], acc[ai][bj][m][n], 0, 0, 0); __builtin_amdgcn_s_setprio(0); } while (0)
#define PG8_WAIT_V(n) asm volatile("s_waitcnt vmcnt(" #n ")" ::: "memory")
#define PG8_WAIT_L(n) asm volatile("s_waitcnt lgkmcnt(" #n ")" ::: "memory")
#define PG8_BAR __builtin_amdgcn_s_barrier()
#define PG8_SCHED __builtin_amdgcn_sched_barrier(0)
    Unit cur, nxt; int ui = 0;
    if (!S.next(0, cur)) return;
    f32x4 acc[2][2][4][2];
#pragma unroll
    for (int a = 0; a < 2; ++a)
#pragma unroll
        for (int b = 0; b < 2; ++b)
#pragma unroll
            for (int m = 0; m < 4; ++m)
#pragma unroll
                for (int n = 0; n < 2; ++n) acc[a][b][m][n] = (f32x4){0.f, 0.f, 0.f, 0.f};
    bf16x8 At[4][2], B0[2][2], B1[2][2];
    const char* cA = (const char*)g.A + (size_t)cur.pm * tstep; const char* cB = (const char*)g.Bt + (size_t)cur.pn * tstep;
    S.a_ready(cur);
    if constexpr (SP2) {
        PG8_STAGE(PG8_SB(0, 0), cB, voffB); PG8_STAGE(PG8_SB(0, 1), cB + hstep, voffB); PG8_STAGE(PG8_SA(0, 0), cA, voffA); PG8_STAGE(PG8_SA(0, 1), cA + hstep, voffA);
        if (wr == 1) PG8_BAR;
        PG8_WAIT_V(2); PG8_BAR;
        PG8_STAGE(PG8_SB(1, 0), cB + kstep, voffB); PG8_STAGE(PG8_SA(1, 0), cA + kstep, voffA); PG8_STAGE(PG8_SB(1, 1), cB + hstep + kstep, voffB);
        PG8_WAIT_V(6); PG8_BAR;
    } else {
        PG8_STAGE(PG8_SB(0, 0), cB, voffB); PG8_STAGE(PG8_SA(0, 0), cA, voffA); PG8_STAGE(PG8_SB(0, 1), cB + hstep, voffB); PG8_STAGE(PG8_SA(0, 1), cA + hstep, voffA);
        if (wr == 1) PG8_BAR;
        PG8_WAIT_V(4); PG8_BAR;
        PG8_STAGE(PG8_SB(1, 0), cB + kstep, voffB); PG8_STAGE(PG8_SA(1, 0), cA + kstep, voffA); PG8_STAGE(PG8_SB(1, 1), cB + hstep + kstep, voffB);
        PG8_WAIT_V(6); PG8_BAR;
    }
    for (;;) {
        const bool has_next = S.next(ui + 1, nxt);
        const char* nA = has_next ? (const char*)g.A + (size_t)nxt.pm * tstep : cA; const char* nB = has_next ? (const char*)g.Bt + (size_t)nxt.pn * tstep : cB;
        for (int t = 0; t < nt; t += 2) {
            const bool last = (t == nt - 2);
            const char* a1 = cA + (size_t)(t + 1) * kstep;
            const char* a2 = last ? nA : cA + (size_t)(t + 2) * kstep; const char* b2 = last ? nB : cB + (size_t)(t + 2) * kstep;
            const char* a3 = a2 + kstep; const char* b3 = b2 + kstep;
            if (last && has_next) S.a_ready(nxt);
            if (t == E.mid_t()) E.mid(acc, cur, wr, wc, fr, fq);
            if constexpr (SP2) {
            PG8_LDB(B0, 0, 0); PG8_LDB(B1, 0, 1); PG8_SCHED; PG8_LDA(At, 0, 0); PG8_STAGE(PG8_SA(1, 1), a1 + hstep, voffA);
            PG8_WAIT_V(8); PG8_WAIT_L(0); PG8_BAR; PG8_MMA(0, 0, At, B0); PG8_MMA(0, 1, At, B1); PG8_BAR; PG8_SCHED;
            PG8_LDA(At, 0, 1); PG8_STAGE(PG8_SB(0, 0), b2, voffB); PG8_STAGE(PG8_SB(0, 1), b2 + hstep, voffB); PG8_STAGE(PG8_SA(0, 0), a2, voffA);
            PG8_WAIT_V(8); PG8_WAIT_L(0); PG8_BAR; PG8_MMA(1, 0, At, B0); PG8_MMA(1, 1, At, B1); PG8_BAR; PG8_SCHED;
            PG8_LDB(B0, 1, 0); PG8_LDB(B1, 1, 1); PG8_SCHED; PG8_LDA(At, 1, 0); PG8_STAGE(PG8_SA(0, 1), a2 + hstep, voffA);
            PG8_WAIT_V(8); PG8_WAIT_L(0); PG8_BAR; PG8_MMA(0, 0, At, B0); PG8_MMA(0, 1, At, B1); PG8_BAR; PG8_SCHED;
            PG8_LDA(At, 1, 1); PG8_STAGE(PG8_SB(1, 0), b3, voffB); PG8_STAGE(PG8_SB(1, 1), b3 + hstep, voffB); PG8_STAGE(PG8_SA(1, 0), a3, voffA);
            PG8_WAIT_V(8); PG8_WAIT_L(0); PG8_BAR; PG8_MMA(1, 0, At, B0); PG8_MMA(1, 1, At, B1); PG8_BAR; PG8_SCHED;
            } else {
            PG8_LDB(B0, 0, 0); PG8_SCHED; PG8_LDA(At, 0, 0); PG8_STAGE(PG8_SA(1, 1), a1 + hstep, voffA);
            PG8_WAIT_L(8); PG8_BAR; PG8_WAIT_L(0); PG8_MMA(0, 0, At, B0); PG8_BAR; PG8_SCHED;
            PG8_LDB(B1, 0, 1); PG8_STAGE(PG8_SB(0, 0), b2, voffB);
            PG8_BAR; PG8_WAIT_L(0); PG8_MMA(0, 1, At, B1); PG8_BAR;
            PG8_LDA(At, 0, 1); PG8_STAGE(PG8_SA(0, 0), a2, voffA);
            PG8_BAR; PG8_WAIT_L(0); PG8_MMA(1, 0, At, B0); PG8_BAR; PG8_SCHED;
            PG8_STAGE(PG8_SB(0, 1), b2 + hstep, voffB);
            PG8_WAIT_V(6); PG8_BAR; PG8_MMA(1, 1, At, B1); PG8_BAR;
            PG8_LDB(B0, 1, 0); PG8_SCHED; PG8_LDA(At, 1, 0); PG8_STAGE(PG8_SA(0, 1), a2 + hstep, voffA);
            PG8_WAIT_L(8); PG8_BAR; PG8_WAIT_L(0); PG8_MMA(0, 0, At, B0); PG8_BAR; PG8_SCHED;
            PG8_LDB(B1, 1, 1); PG8_STAGE(PG8_SB(1, 0), b3, voffB);
            PG8_BAR; PG8_WAIT_L(0); PG8_MMA(0, 1, At, B1); PG8_BAR;
            PG8_LDA(At, 1, 1); PG8_STAGE(PG8_SA(1, 0), a3, voffA);
            PG8_BAR; PG8_WAIT_L(0); PG8_MMA(1, 0, At, B0); PG8_BAR; PG8_SCHED;
            PG8_STAGE(PG8_SB(1, 1), b3 + hstep, voffB);
            PG8_WAIT_V(6); PG8_BAR; PG8_MMA(1, 1, At, B1); PG8_BAR;
            }
        }
        if constexpr (ALIGN_EPI) { if (wr == 0) PG8_BAR; }
        if constexpr (!Epi::AFTER_DRAIN) { E(acc, cur, wr, wc, fr, fq); S.done(cur); }
        if (!has_next) break;
#pragma unroll
        for (int a = 0; a < 2; ++a)
#pragma unroll
            for (int b = 0; b < 2; ++b)
#pragma unroll
                for (int m = 0; m < 4; ++m)
#pragma unroll
                    for (int n = 0; n < 2; ++n) acc[a][b][m][n] = (f32x4){0.f, 0.f, 0.f, 0.f};
        cur = nxt; cA = nA; cB = nB; ++ui;
        if constexpr (ALIGN_EPI) { if (wr == 1) PG8_BAR; }
    }
    PG8_WAIT_V(0);
    if constexpr (!ALIGN_EPI) { if (wr == 0) PG8_BAR; }
    PG8_BAR;
    if constexpr (Epi::AFTER_DRAIN) { E.fused(acc, cur, wr, wc, fr, fq, lds, wid, lane); S.done(cur); }
#undef PG8_SA
#undef PG8_SB
#undef PG8_STAGE
#undef PG8_LDA
#undef PG8_LDB
#undef PG8_MMA
#undef PG8_WAIT_V
#undef PG8_WAIT_L
#undef PG8_BAR
#undef PG8_SCHED
}
}

#define GAS __attribute__((address_space(1)))
#define LAS __attribute__((address_space(3)))
typedef unsigned short bf16_t;
typedef short bf16x8 __attribute__((ext_vector_type(8)));
typedef float f32x4 __attribute__((ext_vector_type(4)));
typedef float f32x16 __attribute__((ext_vector_type(16)));
typedef unsigned u32x4 __attribute__((ext_vector_type(4)));
typedef unsigned u32x2 __attribute__((ext_vector_type(2)));
constexpr int NWAVES = 8, NTHR = 512;
constexpr int M = 16384, D = 1024, NP = 2560, DIN = 2568, DS = 512, NG = 32, NS = 64, NH = 4, DH = 128, DFF = 4096, NCHUNK = 256, CPB = 128, NITEM = 1024;
constexpr float EPS = 1e-6f;
constexpr size_t MiB = 1u << 20, KiB = 1024;
constexpr size_t WS_CTL = 0, CTL_ZERO_BYTES = 64 * KiB;
constexpr size_t WS_W = 1 * MiB, W_LSTRIDE = 24 * MiB;
constexpr size_t OFF_WIN = 0, OFF_WG = 5 * MiB, OFF_WGLU = 5 * MiB + 64 * KiB, OFF_WOUT = 6 * MiB, OFF_W1 = 8 * MiB, OFF_W2 = 16 * MiB;
constexpr size_t KTAB_G = 65 * 256;
constexpr size_t WS_KTAB = 49 * MiB, WS_A64 = 50 * MiB + 256 * KiB, WS_WST = 51 * MiB, WS_GT = 59 * MiB;
constexpr size_t WS_SLOTS = 67 * MiB, WS_SLOTS2 = 68 * MiB, WS_BCUM = 68 * MiB + 512 * KiB, WS_AARR = WS_BCUM + 256 * KiB, WS_PMAX = WS_AARR + 256 * KiB;
constexpr size_t WS_BLAST = WS_PMAX + 256 * KiB, WS_MAXG = WS_BLAST + 4 * KiB, WS_MST = WS_MAXG + 4 * KiB;
constexpr size_t WS_NLOC = 69 * MiB + 512 * KiB, WS_XLOC = 70 * MiB, WS_XPREV = 74 * MiB;
constexpr size_t WS_U2 = 76 * MiB, WS_QRAW = 92 * MiB, WS_Z = WS_QRAW, WS_KRAW = 108 * MiB, WS_VT = 124 * MiB, WS_ORAW = 140 * MiB, WS_QC = 156 * MiB, WS_KC = 172 * MiB;
constexpr size_t WS_DC = 188 * MiB, WS_YCAT = WS_DC, WS_XB = 220 * MiB, WS_CST = WS_XB, WS_H1 = 76 * MiB, WS_GATES = 253 * MiB, WS_END = 254 * MiB;
constexpr size_t WS_NST = WS_GATES + 512 * KiB;
static_assert(WS_CST + (size_t)NITEM * 16384 * 2 <= WS_GATES && WS_NST + 512 * KiB <= WS_END && WS_H1 + (size_t)M * DFF * 2 <= WS_XB && WS_BLAST + 12 * KiB <= WS_NLOC, "ws map");
constexpr int CW_BAR = 4096;
constexpr int RING_BYTES = 131072, LDS_BYTES = 160 * 1024, MISC_OFF = LDS_BYTES - 256;

#define RLX_AGENT __ATOMIC_RELAXED, __HIP_MEMORY_SCOPE_AGENT
#define LDS_WAIT() asm volatile("s_waitcnt lgkmcnt(0)" ::: "memory")
#define VM_WAIT() asm volatile("s_waitcnt vmcnt(0)" ::: "memory")
#define MFMA32(a, b, c) __builtin_amdgcn_mfma_f32_32x32x16_bf16((a), (b), (c), 0, 0, 0)
__device__ __forceinline__ float bf2f(unsigned b) { return __uint_as_float(b << 16); }
__device__ __forceinline__ unsigned f2bf(float f) { unsigned u = __float_as_uint(f); return (u + 0x7fffu + ((u >> 16) & 1u)) >> 16; }
__device__ __forceinline__ unsigned pk2(float lo, float hi) { return f2bf(lo) | (f2bf(hi) << 16); }
__device__ __forceinline__ float wave_sum(float v) {
#pragma unroll
    for (int o = 1; o < 64; o <<= 1) v += __shfl_xor(v, o);
    return v;
}
__device__ __forceinline__ float sigmoid_f(float x) { return 1.0f / (1.0f + __expf(-x)); }
__device__ __forceinline__ float logsigmoid_f(float x) { return fminf(x, 0.f) - log1pf(__expf(-fabsf(x))); }
__device__ __forceinline__ float gelu_tanh(float x) { const float u = 0.7978845608028654f * (x + 0.044715f * x * x * x); const float e = __expf(2.0f * u); const float th = 1.0f - 2.0f / (e + 1.0f); return 0.5f * x * (1.0f + th); }
__device__ __forceinline__ int crow(int reg, int hh) { return (reg & 3) + 8 * (reg >> 2) + 4 * hh; }
__device__ __forceinline__ float sum16(const float* p) { const f32x4 a = ((const f32x4*)p)[0], b = ((const f32x4*)p)[1], c = ((const f32x4*)p)[2], d = ((const f32x4*)p)[3];
    return ((a.x + a.y) + (a.z + a.w)) + ((b.x + b.y) + (b.z + b.w)) + ((c.x + c.y) + (c.z + c.w)) + ((d.x + d.y) + (d.z + d.w)); }
__device__ __forceinline__ float sum8(const float* p) { const f32x4 a = ((const f32x4*)p)[0], b = ((const f32x4*)p)[1]; return ((a.x + a.y) + (a.z + a.w)) + ((b.x + b.y) + (b.z + b.w)); }

#define XB_TMO      128
#define XB_XCNT(j)  (256  + 64 * (j))
#define XB_XSUB(j)  (1280 + 64 * (j))
#define XB_XGEN(j)  (2304 + 64 * (j))
#define XB_TOP      3328
#define XB_TOPGEN   3392
#define XCD_BAR_WORDS 3456
#define XB_SPIN_CAP (1u << 20)
__device__ __forceinline__ unsigned xb_ld(unsigned* p)              { return __hip_atomic_load(p, __ATOMIC_RELAXED, __HIP_MEMORY_SCOPE_AGENT); }
__device__ __forceinline__ unsigned xb_add(unsigned* p, unsigned v) { return __hip_atomic_fetch_add(p, v, __ATOMIC_RELAXED, __HIP_MEMORY_SCOPE_AGENT); }
__device__ __forceinline__ unsigned xb_xcc_id() { return (unsigned)__builtin_amdgcn_s_getreg((3 << 11) | 20) & 0xFu; }
#define XB_SPIN(cond, bar) do { unsigned _sp = 0; while (cond) { __builtin_amdgcn_s_sleep(1); \
    if ((++_sp & 255u) == 0u) { if (xb_ld(&(bar)[XB_TMO])) break; if (_sp > XB_SPIN_CAP) { atomicAdd(&(bar)[XB_TMO], 1u); break; } } } } while (0)
struct XcdBarrier { unsigned* bar; unsigned x; volatile LAS unsigned* st; };
__device__ __forceinline__ XcdBarrier xcd_barrier_post(unsigned* bar, volatile LAS unsigned* st) {
    XcdBarrier b; b.bar = bar; b.x = xb_xcc_id(); b.st = st;
    if (threadIdx.x == 0) (void)xb_add(&bar[XB_XCNT(b.x)], 1u);
    return b;
}
__device__ __forceinline__ void xcd_barrier_complete(unsigned* bar, unsigned x, unsigned& nloc, unsigned& nx) {
    const unsigned G = gridDim.x * gridDim.y * gridDim.z;
    unsigned sum, cnt, mine, sp = 0u;
    for (;;) {
        sum = 0u; cnt = 0u; mine = 0u;
#pragma unroll 1
        for (unsigned j = 0; j < 16; ++j) { const unsigned c = xb_ld(&bar[XB_XCNT(j)]); sum += c; cnt += (c > 0u) ? 1u : 0u; mine = (j == x) ? c : mine; }
        if (sum == G) break;
        __builtin_amdgcn_s_sleep(1);
        if ((++sp & 255u) == 0u) { if (xb_ld(&bar[XB_TMO])) break; if (sp > XB_SPIN_CAP) { atomicAdd(&bar[XB_TMO], 1u); break; } }
    }
    nloc = mine > 0u ? mine : 1u; nx = cnt > 0u ? cnt : 1u;
}
__device__ __forceinline__ void xcd_barrier(const XcdBarrier& b, unsigned* bar_in, bool leader) {
    asm volatile("s_waitcnt vmcnt(0)" ::: "memory");
    __syncthreads();
    if (leader) {
        unsigned* bar = bar_in;
        __builtin_amdgcn_s_waitcnt(0);
        unsigned nloc = b.st[0], nx = b.st[1];
        if (nloc == 0u) { xcd_barrier_complete(bar, b.x, nloc, nx); b.st[0] = nloc; b.st[1] = nx; }
        const unsigned old = xb_add(&bar[XB_XSUB(b.x)], 1u);
        const unsigned gen = old / nloc;
        if (old + 1u == (gen + 1u) * nloc) {
            __builtin_amdgcn_fence(__ATOMIC_RELEASE, "agent");
            asm volatile("s_waitcnt vmcnt(0)" ::: "memory");
            const unsigned og = xb_add(&bar[XB_TOP], 1u);
            const unsigned tg = og / nx;
            if (og + 1u == (tg + 1u) * nx) xb_add(&bar[XB_TOPGEN], 1u);
            else XB_SPIN(xb_ld(&bar[XB_TOPGEN]) == tg, bar);
            __builtin_amdgcn_fence(__ATOMIC_ACQUIRE, "agent");
            xb_add(&bar[XB_XGEN(b.x)], 1u);
            asm volatile("s_waitcnt vmcnt(0)" ::: "memory");
        } else {
            XB_SPIN(xb_ld(&bar[XB_XGEN(b.x)]) == gen, bar);
            __builtin_amdgcn_fence(__ATOMIC_ACQUIRE, "agent");
            asm volatile("s_waitcnt vmcnt(0)" ::: "memory");
        }
    }
    __syncthreads();
}

using pg8::Unit; using pg8::cvt_pk_bf16;
__device__ __forceinline__ float sum_fq(float v) {
    { auto r = __builtin_amdgcn_permlane16_swap(__float_as_uint(v), __float_as_uint(v), false, false); v = __uint_as_float(r[0]) + __uint_as_float(r[1]); }
    { auto r = __builtin_amdgcn_permlane32_swap(__float_as_uint(v), __float_as_uint(v), false, false); v = __uint_as_float(r[0]) + __uint_as_float(r[1]); }
    return v;
}
typedef const f32x4 (&AccC)[2][2][4][2];
typedef f32x4 (&AccM)[2][2][4][2];
__device__ __forceinline__ float sum16o(const unsigned char* base, unsigned off) { const f32x4 a = *(const f32x4*)(base + off), b = *(const f32x4*)(base + off + 16u), c = *(const f32x4*)(base + off + 32u), d = *(const f32x4*)(base + off + 48u);
    return ((a.x + a.y) + (a.z + a.w)) + ((b.x + b.y) + (b.z + b.w)) + ((c.x + c.y) + (c.z + c.w)) + ((d.x + d.y) + (d.z + d.w)); }
__device__ __forceinline__ float sum8o(const unsigned char* base, unsigned off) { const f32x4 a = *(const f32x4*)(base + off), b = *(const f32x4*)(base + off + 16u); return ((a.x + a.y) + (a.z + a.w)) + ((b.x + b.y) + (b.z + b.w)); }
__device__ __forceinline__ void epi_g1(AccC acc, const Unit& u, int wr, int wc, int fr, int fq, unsigned char* ws) {
    const unsigned row0 = (unsigned)(u.pm * 256 + wr * 64 + fr), colt = (unsigned)(u.pn * 256);
#pragma unroll
    for (int ai = 0; ai < 2; ++ai)
#pragma unroll
        for (int m = 0; m < 4; ++m) {
            const unsigned row = row0 + ai * 128 + m * 16;
            const float rs = rsqrtf(sum16o(ws, (unsigned)WS_SLOTS + row * 64u) * (1.0f / D) + EPS);
#pragma unroll
            for (int bj = 0; bj < 2; ++bj) {
                const unsigned c0 = colt + bj * 128 + wc * 32 + 8 * fq;
                const f32x4 v0 = acc[ai][bj][m][0] * rs, v1 = acc[ai][bj][m][1] * rs;
                u32x4 w; w.x = cvt_pk_bf16(v0[0], v0[1]); w.y = cvt_pk_bf16(v0[2], v0[3]); w.z = cvt_pk_bf16(v1[0], v1[1]); w.w = cvt_pk_bf16(v1[2], v1[3]);
                if (u.pn < 2) { const unsigned g = c0 >> 4, p0 = c0 & 15u; *(u32x4*)(ws + ((unsigned)WS_U2 + (g * (unsigned)M + row) * 32u + p0 * 2u)) = w; }
                else if (u.pn == 6 || u.pn == 7) {
                    const unsigned cv = c0 - 1536u, hh = cv >> 7, dv = cv & 127u, cid = row >> 6, s = row & 63u;
                    bf16_t* b = (bf16_t*)(ws + ((unsigned)WS_VT + ((cid * 4u + hh) * 8192u + (((s >> 4) * 128u + dv) * 16u + (s & 15u))) * 2u));
                    b[0] = (bf16_t)(w.x & 0xffffu); b[16] = (bf16_t)(w.x >> 16); b[32] = (bf16_t)(w.y & 0xffffu); b[48] = (bf16_t)(w.y >> 16);
                    b[64] = (bf16_t)(w.z & 0xffffu); b[80] = (bf16_t)(w.z >> 16); b[96] = (bf16_t)(w.w & 0xffffu); b[112] = (bf16_t)(w.w >> 16);
                } else {
                    const unsigned toff = u.pn < 4 ? (unsigned)WS_QRAW : (u.pn < 6 ? (unsigned)WS_KRAW : (unsigned)WS_ORAW), cb = c0 - (u.pn < 4 ? 512u : (u.pn < 6 ? 1024u : 2048u));
                    *(u32x4*)(ws + (toff + (row * 512u + cb) * 2u)) = w;
                }
            }
            asm volatile("" ::: "memory");
        }
}
__device__ __forceinline__ void epi_g2(AccC acc, const Unit& u, int wr, int wc, int fr, int fq, unsigned char* ws, const float* bglu) {
    const unsigned row0 = (unsigned)(u.pm * 256 + wr * 64 + fr), colt = (unsigned)(u.pn * 256);
#pragma unroll
    for (int ai = 0; ai < 2; ++ai)
#pragma unroll
        for (int m = 0; m < 4; ++m) {
            const unsigned row = row0 + ai * 128 + m * 16; float ss = 0.f;
#pragma unroll
            for (int bj = 0; bj < 2; ++bj) {
                const unsigned c0 = colt + bj * 128 + wc * 32 + 8 * fq;
                const u32x4 zv = *(const u32x4*)(ws + ((unsigned)WS_Z + (row * 512u + c0) * 2u));
                const f32x4 b0 = *(const f32x4*)((const unsigned char*)bglu + c0 * 4u), b1 = *(const f32x4*)((const unsigned char*)bglu + c0 * 4u + 16u);
                const f32x4 a0 = acc[ai][bj][m][0] + b0, a1 = acc[ai][bj][m][1] + b1;
                float zz[8];
                zz[0] = bf2f(zv.x & 0xffffu) * sigmoid_f(a0[0]); zz[1] = bf2f(zv.x >> 16) * sigmoid_f(a0[1]);
                zz[2] = bf2f(zv.y & 0xffffu) * sigmoid_f(a0[2]); zz[3] = bf2f(zv.y >> 16) * sigmoid_f(a0[3]);
                zz[4] = bf2f(zv.z & 0xffffu) * sigmoid_f(a1[0]); zz[5] = bf2f(zv.z >> 16) * sigmoid_f(a1[1]);
                zz[6] = bf2f(zv.w & 0xffffu) * sigmoid_f(a1[2]); zz[7] = bf2f(zv.w >> 16) * sigmoid_f(a1[3]);
#pragma unroll
                for (int j = 0; j < 8; ++j) ss += zz[j] * zz[j];
                u32x4 w; w.x = cvt_pk_bf16(zz[0], zz[1]); w.y = cvt_pk_bf16(zz[2], zz[3]); w.z = cvt_pk_bf16(zz[4], zz[5]); w.w = cvt_pk_bf16(zz[6], zz[7]);
                *(u32x4*)(ws + ((unsigned)WS_YCAT + (row * 1024u + c0) * 2u)) = w;
            }
            ss = sum_fq(ss);
            if (fq == 0) *(float*)(ws + ((unsigned)WS_SLOTS2 + (row * 8u + (unsigned)(u.pn * 4 + wc)) * 4u)) = ss;
            asm volatile("" ::: "memory");
        }
}
__device__ __forceinline__ void mid_g3(AccM acc, const Unit& u, int wr, int fr, unsigned char* ws) {
    const unsigned row0 = (unsigned)(u.pm * 256 + wr * 64 + fr);
#pragma unroll
    for (int ai = 0; ai < 2; ++ai)
#pragma unroll
        for (int m = 0; m < 4; ++m) {
            const unsigned row = row0 + ai * 128 + m * 16;
            const float r = rsqrtf(sum8o(ws, (unsigned)WS_SLOTS2 + row * 32u) * (1.0f / DS) + EPS);
#pragma unroll
            for (int bj = 0; bj < 2; ++bj)
#pragma unroll
                for (int n = 0; n < 2; ++n) acc[ai][bj][m][n] = acc[ai][bj][m][n] * r;
            asm volatile("" ::: "memory");
        }
}
__device__ __forceinline__ void epi_res(AccC acc, const Unit& u, int wr, int wc, int fr, int fq, unsigned char* ws, const bf16_t* xold, bf16_t* xnew) {
    const unsigned row0 = (unsigned)(u.pm * 256 + wr * 64 + fr), colt = (unsigned)(u.pn * 256);
#pragma unroll
    for (int ai = 0; ai < 2; ++ai)
#pragma unroll
        for (int m = 0; m < 4; ++m) {
            const unsigned row = row0 + ai * 128 + m * 16; float ss = 0.f;
#pragma unroll
            for (int bj = 0; bj < 2; ++bj) {
                const unsigned o = (row * 1024u + colt + bj * 128 + wc * 32 + 8 * fq) * 2u;
                const u32x4 xv = *(const u32x4*)((const unsigned char*)xold + o);
                const f32x4 a0 = acc[ai][bj][m][0], a1 = acc[ai][bj][m][1];
                float x[8];
                x[0] = bf2f(xv.x & 0xffffu) + a0[0]; x[1] = bf2f(xv.x >> 16) + a0[1]; x[2] = bf2f(xv.y & 0xffffu) + a0[2]; x[3] = bf2f(xv.y >> 16) + a0[3];
                x[4] = bf2f(xv.z & 0xffffu) + a1[0]; x[5] = bf2f(xv.z >> 16) + a1[1]; x[6] = bf2f(xv.w & 0xffffu) + a1[2]; x[7] = bf2f(xv.w >> 16) + a1[3];
#pragma unroll
                for (int j = 0; j < 8; ++j) ss += x[j] * x[j];
                u32x4 w; w.x = cvt_pk_bf16(x[0], x[1]); w.y = cvt_pk_bf16(x[2], x[3]); w.z = cvt_pk_bf16(x[4], x[5]); w.w = cvt_pk_bf16(x[6], x[7]);
                *(u32x4*)((unsigned char*)xnew + o) = w;
            }
            ss = sum_fq(ss);
            if (fq == 0) *(float*)(ws + ((unsigned)WS_SLOTS + (row * 16u + (unsigned)(u.pn * 4 + wc)) * 4u)) = ss;
            asm volatile("" ::: "memory");
        }
}
__device__ __forceinline__ void epi_g4(AccC acc, const Unit& u, int wr, int wc, int fr, int fq, unsigned char* ws) {
    const unsigned row0 = (unsigned)(u.pm * 256 + wr * 64 + fr), colt = (unsigned)(u.pn * 256);
#pragma unroll
    for (int ai = 0; ai < 2; ++ai)
#pragma unroll
        for (int m = 0; m < 4; ++m) {
            const unsigned row = row0 + ai * 128 + m * 16;
            const float r2 = 1.0f / (sum16o(ws, (unsigned)WS_SLOTS + row * 64u) * (1.0f / D) + EPS);
#pragma unroll
            for (int bj = 0; bj < 2; ++bj) {
                const unsigned c0 = colt + bj * 128 + wc * 32 + 8 * fq;
                f32x4 v0 = acc[ai][bj][m][0], v1 = acc[ai][bj][m][1];
#pragma unroll
                for (int j = 0; j < 4; ++j) { const float a = fmaxf(v0[j], 0.f), b = fmaxf(v1[j], 0.f); v0[j] = a * a * r2; v1[j] = b * b * r2; }
                u32x4 w; w.x = cvt_pk_bf16(v0[0], v0[1]); w.y = cvt_pk_bf16(v0[2], v0[3]); w.z = cvt_pk_bf16(v1[0], v1[1]); w.w = cvt_pk_bf16(v1[2], v1[3]);
                *(u32x4*)(ws + ((unsigned)WS_H1 + (row * (unsigned)DFF + c0) * 2u)) = w;
            }
            asm volatile("" ::: "memory");
        }
}
template <int KIND> struct EpiK {
    static constexpr bool AFTER_DRAIN = false;
    unsigned char* ws; const void* aux; void* xo;
    __device__ __forceinline__ constexpr bool perm() const { return true; }
    __device__ __forceinline__ constexpr int mid_t() const { return KIND == 3 ? 8 : -1; }
    __device__ __forceinline__ void mid(AccM acc, const Unit& u, int wr, int wc, int fr, int fq) const { if constexpr (KIND == 3) mid_g3(acc, u, wr, fr, ws); }
    __device__ __forceinline__ void operator()(AccC acc, const Unit& u, int wr, int wc, int fr, int fq) const {
        if constexpr (KIND == 1) epi_g1(acc, u, wr, wc, fr, fq, ws);
        else if constexpr (KIND == 2) epi_g2(acc, u, wr, wc, fr, fq, ws, (const float*)aux);
        else if constexpr (KIND == 4) epi_g4(acc, u, wr, wc, fr, fq, ws);
        else epi_res(acc, u, wr, wc, fr, fq, ws, (const bf16_t*)aux, (bf16_t*)xo);
    }
};

struct Args { const float* in[24]; float* out; unsigned char* ws; int ph_lo, ph_hi, flags, pad; };
struct Env {
    volatile LAS unsigned* pt;
    __device__ __forceinline__ unsigned long long ptr(int i) const { const unsigned lo = pt[2 * i], hi = pt[2 * i + 1];
        return ((unsigned long long)(unsigned)__builtin_amdgcn_readfirstlane((int)hi) << 32) | (unsigned)__builtin_amdgcn_readfirstlane((int)lo); }
    __device__ __forceinline__ const float* in(int i) const { return (const float*)ptr(i); }
    __device__ __forceinline__ float* out() const { return (float*)ptr(24); }
    __device__ __forceinline__ unsigned char* ws() const { return (unsigned char*)ptr(25); }
};

__device__ __forceinline__ void p0_transpose_item(const float* W, int ldw, int K, int nblk, const float* kscale, int kslen, bf16_t* WT, LAS float* scr, int item, int lane) {
    const int kb = item / nblk, nb = item % nblk, k0 = 64 * kb, n0 = 64 * nb;
    const int lr = lane >> 4, lc = (lane & 15) * 4;
    f32x4 v[16];
#pragma unroll
    for (int i = 0; i < 16; ++i) v[i] = *(const f32x4*)(W + (size_t)(k0 + 4 * i + lr) * ldw + n0 + lc);
#pragma unroll
    for (int i = 0; i < 16; ++i) { const int kk = 4 * i + lr; const float sc = (k0 + kk < kslen) ? kscale[k0 + kk] : 1.0f; LAS float* d = scr + kk * 65 + lc;
        d[0] = v[i].x * sc; d[1] = v[i].y * sc; d[2] = v[i].z * sc; d[3] = v[i].w * sc; }
    LDS_WAIT(); asm volatile("" ::: "memory");
    const int c = lane & 7;
#pragma unroll
    for (int j = 0; j < 8; ++j) { const int n = (lane >> 3) + 8 * j; const LAS float* s = scr + (8 * c) * 65 + n;
        u32x4 o; o.x = pk2(s[0 * 65], s[1 * 65]); o.y = pk2(s[2 * 65], s[3 * 65]); o.z = pk2(s[4 * 65], s[5 * 65]); o.w = pk2(s[6 * 65], s[7 * 65]);
        *(u32x4*)(WT + (size_t)(n0 + n) * K + k0 + 8 * c) = o; }
    LDS_WAIT(); asm volatile("" ::: "memory");
}
__device__ __forceinline__ void p0_weights(const Env& A, int l, LAS unsigned char* lds, int wave, int lane, int gw, int NGW) {
    unsigned char* const ws = A.ws(); const float* const i1 = A.in(1); const float* const i2 = A.in(2); const float* const i11 = A.in(11); const float* const i13 = A.in(13);
    const float* const i19 = A.in(19); const float* const i20 = A.in(20); const float* const i21 = A.in(21); const float* const i22 = A.in(22);
    LAS float* scr = (LAS float*)(lds + wave * 16640);
    constexpr int I_IN = 16 * 40, I_GLU = 8 * 8, I_OUT = 16 * 16, I_1 = 16 * 64, I_2 = 64 * 16, I_G = 16, I_L = I_IN + I_GLU + I_OUT + I_1 + I_2 + I_G;
    unsigned char* wb = ws + WS_W + (size_t)l * W_LSTRIDE;
    for (int it = gw; it < I_L; it += NGW) {
        int r = it;
        if (r < I_IN) { p0_transpose_item(i2 + (size_t)l * D * DIN, DIN, D, 40, i1 + l * D, D, (bf16_t*)(wb + OFF_WIN), scr, r, lane); continue; } r -= I_IN;
        if (r < I_GLU) { p0_transpose_item(i11 + (size_t)l * DS * DS, DS, DS, 8, nullptr, 0, (bf16_t*)(wb + OFF_WGLU), scr, r, lane); continue; } r -= I_GLU;
        if (r < I_OUT) { p0_transpose_item(i19 + (size_t)l * D * D, D, D, 16, i13 + l * DS, DS, (bf16_t*)(wb + OFF_WOUT), scr, r, lane); continue; } r -= I_OUT;
        if (r < I_1) { p0_transpose_item(i21 + (size_t)l * D * DFF, DFF, D, 64, i20 + l * D, D, (bf16_t*)(wb + OFF_W1), scr, r, lane); continue; } r -= I_1;
        if (r < I_2) { p0_transpose_item(i22 + (size_t)l * DFF * D, D, DFF, 16, nullptr, 0, (bf16_t*)(wb + OFF_W2), scr, r, lane); continue; } r -= I_2;
        { const int k = 64 * r + lane; bf16_t* wg = (bf16_t*)(wb + OFF_WG);
#pragma unroll
          for (int j = 0; j < 32; ++j) { const float v = j < 8 ? i1[l * D + k] * i2[(size_t)l * D * DIN + (size_t)k * DIN + 2560 + j] : 0.f; wg[j * 1024 + k] = (bf16_t)f2bf(v); } }
    }
}
__device__ __forceinline__ void rpass(const float* src, bf16_t* XB, unsigned char* ws, int wave, int lane) {
    const int gw = blockIdx.x * NWAVES + wave, NGW = gridDim.x * NWAVES;
    float* slots = (float*)(ws + WS_SLOTS);
    for (int m = gw; m < M; m += 2 * NGW) {
        const int m2 = m + NGW; const bool has2 = m2 < M;
        const f32x4* xr = (const f32x4*)(src + (size_t)m * D) + lane; const f32x4* xr2 = (const f32x4*)(src + (size_t)(has2 ? m2 : m) * D) + lane;
        f32x4 v[4], w[4]; float s = 0.f, s2 = 0.f;
#pragma unroll
        for (int j = 0; j < 4; ++j) { v[j] = xr[64 * j]; w[j] = xr2[64 * j]; }
#pragma unroll
        for (int j = 0; j < 4; ++j) { s += (v[j].x * v[j].x + v[j].y * v[j].y) + (v[j].z * v[j].z + v[j].w * v[j].w); s2 += (w[j].x * w[j].x + w[j].y * w[j].y) + (w[j].z * w[j].z + w[j].w * w[j].w); }
        s = wave_sum(s); s2 = wave_sum(s2);
        u32x2* o8 = (u32x2*)(XB + (size_t)m * D) + lane;
#pragma unroll
        for (int j = 0; j < 4; ++j) { u32x2 q; q.x = pk2(v[j].x, v[j].y); q.y = pk2(v[j].z, v[j].w); o8[64 * j] = q; }
        if (lane < 16) slots[(size_t)m * 16 + lane] = lane == 0 ? s : 0.f;
        if (has2) {
            u32x2* o9 = (u32x2*)(XB + (size_t)m2 * D) + lane;
#pragma unroll
            for (int j = 0; j < 4; ++j) { u32x2 q; q.x = pk2(w[j].x, w[j].y); q.y = pk2(w[j].z, w[j].w); o9[64 * j] = q; }
            if (lane < 16) slots[(size_t)m2 * 16 + lane] = lane == 0 ? s2 : 0.f;
        }
    }
}
__device__ __forceinline__ void build_tables(const Env& A, int l, int g, int j, LAS unsigned char* lds, int tid) {
    LAS float* pwr = (LAS float*)lds;
    LAS float* pwi = pwr + 65 * 64;
    LAS float* bbr = pwi + 65 * 64;
    LAS float* bbi = bbr + 1024;
    LAS float* cr = bbi + 1024;
    LAS float* ci = cr + 1024;
    const int lg = l * NG + g;
    unsigned char* const ws = A.ws(); const float* const i3 = A.in(3); const float* const i4 = A.in(4); const float* const i5 = A.in(5); const float* const i6 = A.in(6);
    const float* const i7 = A.in(7); const float* const i8 = A.in(8); const float* const i9 = A.in(9);
    bf16_t* KTAB = (bf16_t*)(ws + WS_KTAB) + (size_t)g * KTAB_G;
    bf16_t* WST = (bf16_t*)(ws + WS_WST) + (size_t)g * 128 * 1024;
    bf16_t* GT = (bf16_t*)(ws + WS_GT) + (size_t)g * 1024 * 128;
    float* A64 = (float*)(ws + WS_A64);
    if (tid < 64) {
        const int n = tid;
        const float are = i3[lg * NS + n], aim = i4[lg * NS + n], dt = expf(i5[lg]);
        const float mag = expf(are * dt), abr = mag * cosf(aim * dt), abi = mag * sinf(aim * dt);
        const float den = are * are + aim * aim, zr = abr - 1.0f;
        const float sr = (zr * are + abi * aim) / den, si = (abi * are - zr * aim) / den;
#pragma unroll
        for (int q = 0; q < 16; ++q) { const float br = i6[(size_t)(lg * NS + n) * 16 + q], bi = i7[(size_t)(lg * NS + n) * 16 + q];
            bbr[n * 16 + q] = sr * br - si * bi; bbi[n * 16 + q] = sr * bi + si * br; }
        double pr = 1.0, pi = 0.0; const double ar = (double)abr, ai = (double)abi;
        for (int tau = 0; tau <= 64; ++tau) { pwr[tau * 64 + n] = (float)pr; pwi[tau * 64 + n] = (float)pi; const double t = pr * ar - pi * ai; pi = pr * ai + pi * ar; pr = t; }
        if (j == 0) { A64[(g * 64 + n) * 2] = pwr[64 * 64 + n]; A64[(g * 64 + n) * 2 + 1] = pwi[64 * 64 + n]; }
    }
    for (int i = tid; i < 1024; i += NTHR) { cr[i] = i8[(size_t)lg * 1024 + i]; ci[i] = i9[(size_t)lg * 1024 + i]; }
    __syncthreads();
    {
        const int pair = tid >> 2, nq = tid & 3, tau = 8 * j + (pair >> 4), p = pair & 15;
        float acc[16];
#pragma unroll
        for (int q = 0; q < 16; ++q) acc[q] = 0.f;
#pragma unroll 2
        for (int n = 16 * nq; n < 16 * nq + 16; ++n) {
            const float c_r = cr[p * 64 + n], c_i = ci[p * 64 + n], p_r = pwr[tau * 64 + n], p_i = pwi[tau * 64 + n];
            const float xr = c_r * p_r - c_i * p_i, xi = c_r * p_i + c_i * p_r;
#pragma unroll
            for (int q4 = 0; q4 < 4; ++q4) { const f32x4 br = *(const LAS f32x4*)(bbr + n * 16 + 4 * q4), bi = *(const LAS f32x4*)(bbi + n * 16 + 4 * q4);
                acc[4 * q4] += xr * br.x - xi * bi.x; acc[4 * q4 + 1] += xr * br.y - xi * bi.y; acc[4 * q4 + 2] += xr * br.z - xi * bi.z; acc[4 * q4 + 3] += xr * br.w - xi * bi.w; }
        }
#pragma unroll
        for (int q = 0; q < 16; ++q) { acc[q] += __shfl_xor(acc[q], 1); acc[q] += __shfl_xor(acc[q], 2); }
        if (nq == 0) { u32x4 o0, o1; o0.x = pk2(acc[0], acc[1]); o0.y = pk2(acc[2], acc[3]); o0.z = pk2(acc[4], acc[5]); o0.w = pk2(acc[6], acc[7]);
            o1.x = pk2(acc[8], acc[9]); o1.y = pk2(acc[10], acc[11]); o1.z = pk2(acc[12], acc[13]); o1.w = pk2(acc[14], acc[15]);
            *(u32x4*)(KTAB + (tau + 1) * 256 + p * 16) = o0; *(u32x4*)(KTAB + (tau + 1) * 256 + p * 16 + 8) = o1; }
    }
    if (j == 0) for (int e = tid; e < 256; e += NTHR) KTAB[e] = 0;
    for (int e = tid; e < 2048; e += NTHR) {
        const int np = 16 * j + (e >> 7), oc = e & 127, n = np & 63, im = np >> 6, k0 = oc * 8, s = k0 >> 4, q0 = k0 & 15;
        const float p_r = pwr[(63 - s) * 64 + n], p_i = pwi[(63 - s) * 64 + n]; float v[8];
#pragma unroll
        for (int jj = 0; jj < 8; ++jj) { const float b_r = bbr[n * 16 + q0 + jj], b_i = bbi[n * 16 + q0 + jj]; v[jj] = im ? (p_r * b_i + p_i * b_r) : (p_r * b_r - p_i * b_i); }
        u32x4 o; o.x = pk2(v[0], v[1]); o.y = pk2(v[2], v[3]); o.z = pk2(v[4], v[5]); o.w = pk2(v[6], v[7]);
        *(u32x4*)(WST + (size_t)((s * 128 + np) * 16 + q0)) = o;
    }
    for (int e = tid; e < 2048; e += NTHR) {
        const int rl = e >> 4, oc = e & 15, t = 8 * j + (rl >> 4), p = rl & 15, np0 = oc * 8; float v[8];
#pragma unroll
        for (int jj = 0; jj < 8; ++jj) { const int np = np0 + jj, n = np & 63; const float p_r = pwr[(t + 1) * 64 + n], p_i = pwi[(t + 1) * 64 + n], c_r = cr[p * 64 + n], c_i = ci[p * 64 + n];
            v[jj] = (np >> 6) ? -(c_r * p_i + c_i * p_r) : (c_r * p_r - c_i * p_i); }
        u32x4 o; o.x = pk2(v[0], v[1]); o.y = pk2(v[2], v[3]); o.z = pk2(v[4], v[5]); o.w = pk2(v[6], v[7]);
        *(u32x4*)(GT + (size_t)(((oc >> 1) * 1024 + t * 16 + p) * 16 + (oc & 1) * 8)) = o;
    }
    __syncthreads();
}

constexpr int USTR = 2048 + 16;
__device__ __forceinline__ void s5a_item(unsigned char* ws, int g, int rb, LAS unsigned char* lds, int tid, int wave, int lane) {
    const unsigned char* U2b = (const unsigned char*)((const bf16_t*)(ws + WS_U2) + ((size_t)g * M + (size_t)rb * 2048) * 16);
    const bf16_t* WST = (const bf16_t*)(ws + WS_WST) + (size_t)g * 128 * 1024;
    float* XLOC = (float*)(ws + WS_XLOC);
    {   u32x4 t[8];
#pragma unroll
        for (int i = 0; i < 8; ++i) t[i] = *(const u32x4*)(U2b + (unsigned)((tid + i * NTHR) * 16));
#pragma unroll
        for (int i = 0; i < 8; ++i) { const int idx = tid + i * NTHR; *(LAS u32x4*)(lds + (idx >> 7) * USTR + (idx & 127) * 16) = t[i]; }
    }
    __syncthreads();
    const int r = lane & 31, hh = lane >> 5, nt = wave & 3, kh = wave >> 2;
    f32x16 acc; for (int i = 0; i < 16; ++i) acc[i] = 0.f;
    const LAS unsigned char* ap = lds + r * USTR + kh * 1024 + hh * 16;
    const bf16_t* bp = WST + (unsigned)(((kh * 32) * 128 + nt * 32 + r) * 16 + 8 * hh);
#pragma unroll 8
    for (int ks = 0; ks < 32; ++ks) { const bf16x8 a = *(const LAS bf16x8*)(ap + ks * 32), b = *(const bf16x8*)(bp + (unsigned)(ks * 2048)); acc = MFMA32(a, b, acc); }
    __syncthreads();
    LAS float* part = (LAS float*)lds + nt * 1024;
    if (kh == 1) {
#pragma unroll
        for (int reg = 0; reg < 16; ++reg) part[crow(reg, hh) * 32 + r] = acc[reg];
    }
    __syncthreads();
    if (kh == 0) {
#pragma unroll
        for (int reg = 0; reg < 16; ++reg) { const int row = crow(reg, hh), cid = rb * 32 + row; XLOC[((size_t)cid * 32 + g) * 128 + nt * 32 + r] = acc[reg] + part[row * 32 + r]; }
    }
    __syncthreads();
}
__device__ __forceinline__ void gates_wave(unsigned char* ws, const bf16_t* XB, int l, int it0, int nit, int stride, int lane_in) {
    int lane = lane_in; asm volatile("" : "+v"(lane)); __builtin_assume(lane >= 0 && lane < 64);
    const bf16_t* WG = (const bf16_t*)(ws + WS_W + (size_t)l * W_LSTRIDE + OFF_WG);
    float wg[8][16];
#pragma unroll
    for (int j = 0; j < 8; ++j) { const u32x4 a = *(const u32x4*)(WG + (unsigned)(j * 1024 + 16 * lane)), b = *(const u32x4*)(WG + (unsigned)(j * 1024 + 16 * lane + 8));
        wg[j][0] = bf2f(a.x & 0xffffu); wg[j][1] = bf2f(a.x >> 16); wg[j][2] = bf2f(a.y & 0xffffu); wg[j][3] = bf2f(a.y >> 16); wg[j][4] = bf2f(a.z & 0xffffu); wg[j][5] = bf2f(a.z >> 16); wg[j][6] = bf2f(a.w & 0xffffu); wg[j][7] = bf2f(a.w >> 16);
        wg[j][8] = bf2f(b.x & 0xffffu); wg[j][9] = bf2f(b.x >> 16); wg[j][10] = bf2f(b.y & 0xffffu); wg[j][11] = bf2f(b.y >> 16); wg[j][12] = bf2f(b.z & 0xffffu); wg[j][13] = bf2f(b.z >> 16); wg[j][14] = bf2f(b.w & 0xffffu); wg[j][15] = bf2f(b.w >> 16); }
    for (int it = it0; it < nit; it += stride) {
        const int rowb = it * 8;
        float v[64];
        u32x4 xa[8], xb2[8];
#pragma unroll
        for (int i = 0; i < 8; ++i) { xa[i] = *(const u32x4*)(XB + (unsigned)((rowb + i) * 1024 + 16 * lane)); xb2[i] = *(const u32x4*)(XB + (unsigned)((rowb + i) * 1024 + 16 * lane + 8)); }
#pragma unroll
        for (int i = 0; i < 8; ++i) {
            float x[16];
            x[0] = bf2f(xa[i].x & 0xffffu); x[1] = bf2f(xa[i].x >> 16); x[2] = bf2f(xa[i].y & 0xffffu); x[3] = bf2f(xa[i].y >> 16); x[4] = bf2f(xa[i].z & 0xffffu); x[5] = bf2f(xa[i].z >> 16); x[6] = bf2f(xa[i].w & 0xffffu); x[7] = bf2f(xa[i].w >> 16);
            x[8] = bf2f(xb2[i].x & 0xffffu); x[9] = bf2f(xb2[i].x >> 16); x[10] = bf2f(xb2[i].y & 0xffffu); x[11] = bf2f(xb2[i].y >> 16); x[12] = bf2f(xb2[i].z & 0xffffu); x[13] = bf2f(xb2[i].z >> 16); x[14] = bf2f(xb2[i].w & 0xffffu); x[15] = bf2f(xb2[i].w >> 16);
#pragma unroll
            for (int j = 0; j < 8; ++j) { float s = 0.f;
#pragma unroll
                for (int k = 0; k < 16; ++k) s += x[k] * wg[j][k];
                v[i * 8 + j] = s; }
        }
#pragma unroll
        for (int c = 32; c >= 1; c >>= 1) {
            const bool up = (lane & c) != 0;
#pragma unroll
            for (int m = 0; m < c; ++m) { const float keep = up ? v[m + c] : v[m], send = up ? v[m] : v[m + c]; v[m] = keep + __shfl_xor(send, c); }
        }
        const int row = rowb + (lane >> 3);
        const float rs = rsqrtf(sum16((const float*)(ws + WS_SLOTS) + (size_t)row * 16) * (1.0f / D) + EPS);
        ((float*)(ws + WS_GATES))[(size_t)rowb * 8 + lane] = v[0] * rs;
    }
}
constexpr int KTS = 72, MLA_LDS = 128 * KTS * 2;
__device__ __forceinline__ void mla_wave(const Env& A, int l, int cid, int h, LAS unsigned char* wl, int lane_in) {
    int lane = lane_in; asm volatile("" : "+v"(lane)); __builtin_assume(lane >= 0 && lane < 64);
    unsigned char* const ws = A.ws(); const float* const i14 = A.in(14); const float* const i15 = A.in(15); const float* const i16 = A.in(16); const float* const i17 = A.in(17);
    const bf16_t* QRAW = (const bf16_t*)(ws + WS_QRAW); const bf16_t* KRAW = (const bf16_t*)(ws + WS_KRAW);
    const int item = cid * 4 + h, row0 = cid * 64, r = lane & 31, hh = lane >> 5;
    bf16_t* QC = (bf16_t*)(ws + WS_QC) + (size_t)item * 8192; bf16_t* KC = (bf16_t*)(ws + WS_KC) + (size_t)item * 8192;
    LAS bf16_t* kT = (LAS bf16_t*)wl;
    float wt;
    {
        const float* G = (const float*)(ws + WS_GATES) + (size_t)(row0 + lane) * 8;
        const float ig = G[h] + i16[l * NH + h], lf = logsigmoid_f(G[4 + h] + i17[l * NH + h]);
        float bc = lf;
#pragma unroll
        for (int o = 1; o < 64; o <<= 1) { const float v = __shfl_up(bc, o); if (lane >= o) bc += v; }
        const float a = ig - bc; float pm = a;
#pragma unroll
        for (int o = 1; o < 64; o <<= 1) { const float v = __shfl_up(pm, o); if (lane >= o) pm = fmaxf(pm, v); }
        const float amax = __shfl(pm, 63), blast = __shfl(bc, 63);
        ((float*)(ws + WS_BCUM))[item * 64 + lane] = bc; ((float*)(ws + WS_AARR))[item * 64 + lane] = a; ((float*)(ws + WS_PMAX))[item * 64 + lane] = pm;
        if (lane == 0) { ((float*)(ws + WS_BLAST))[item] = blast; ((float*)(ws + WS_MAXG))[item] = blast + amax; }
        wt = __expf(a - amax);
    }
    {
        const int c = h * DH + 2 * lane;
        const float* cw = i14 + l * 4 * 1024; const float* cb = i15 + l * 1024;
        float wq0[4], wq1[4], wk0[4], wk1[4];
#pragma unroll
        for (int jj = 0; jj < 4; ++jj) { wq0[jj] = cw[jj * 1024 + c]; wq1[jj] = cw[jj * 1024 + c + 1]; wk0[jj] = cw[jj * 1024 + 512 + c]; wk1[jj] = cw[jj * 1024 + 512 + c + 1]; }
        const float bq0 = cb[c], bq1 = cb[c + 1], bk0 = cb[512 + c], bk1 = cb[512 + c + 1];
        const float kscale = 0.08838834764831845f;
        const bool first = (cid & (CPB - 1)) == 0;
        unsigned hq[3] = {0u, 0u, 0u}, hk[3] = {0u, 0u, 0u};
        if (!first) {
#pragma unroll
            for (int i = 0; i < 3; ++i) { hq[i] = *(const unsigned*)(QRAW + (unsigned)((row0 - 3 + i) * 512 + c)); hk[i] = *(const unsigned*)(KRAW + (unsigned)((row0 - 3 + i) * 512 + c)); }
        }
        float q0a = bf2f(hq[0] & 0xffffu), q0b = bf2f(hq[1] & 0xffffu), q0c = bf2f(hq[2] & 0xffffu), q1a = bf2f(hq[0] >> 16), q1b = bf2f(hq[1] >> 16), q1c = bf2f(hq[2] >> 16);
        float k0a = bf2f(hk[0] & 0xffffu), k0b = bf2f(hk[1] & 0xffffu), k0c = bf2f(hk[2] & 0xffffu), k1a = bf2f(hk[0] >> 16), k1b = bf2f(hk[1] >> 16), k1c = bf2f(hk[2] >> 16);
        for (int t0 = 0; t0 < 64; t0 += 8) {
            unsigned uq[8], uk[8];
#pragma unroll
            for (int i = 0; i < 8; ++i) { uq[i] = *(const unsigned*)(QRAW + (unsigned)((row0 + t0 + i) * 512 + c)); uk[i] = *(const unsigned*)(KRAW + (unsigned)((row0 + t0 + i) * 512 + c)); }
#pragma unroll
            for (int i = 0; i < 8; ++i) {
                const int t = t0 + i;
                const float q0d = bf2f(uq[i] & 0xffffu), q1d = bf2f(uq[i] >> 16), k0d = bf2f(uk[i] & 0xffffu), k1d = bf2f(uk[i] >> 16);
                const float aq0 = bq0 + wq0[0] * q0a + wq0[1] * q0b + wq0[2] * q0c + wq0[3] * q0d, aq1 = bq1 + wq1[0] * q1a + wq1[1] * q1b + wq1[2] * q1c + wq1[3] * q1d;
                const float ak0 = bk0 + wk0[0] * k0a + wk0[1] * k0b + wk0[2] * k0c + wk0[3] * k0d, ak1 = bk1 + wk1[0] * k1a + wk1[1] * k1b + wk1[2] * k1c + wk1[3] * k1d;
                q0a = q0b; q0b = q0c; q0c = q0d; q1a = q1b; q1b = q1c; q1c = q1d; k0a = k0b; k0b = k0c; k0c = k0d; k1a = k1b; k1b = k1c; k1c = k1d;
                const float qv0 = aq0 * sigmoid_f(aq0), qv1 = aq1 * sigmoid_f(aq1), kv0 = ak0 * sigmoid_f(ak0) * kscale, kv1 = ak1 * sigmoid_f(ak1) * kscale;
                *(unsigned*)(QC + (unsigned)(((lane >> 3) * 64 + t) * 16 + 2 * (lane & 7))) = pk2(qv0, qv1);
                const unsigned kb = pk2(kv0, kv1);
                *(unsigned*)(KC + (unsigned)(((lane >> 3) * 64 + t) * 16 + 2 * (lane & 7))) = kb;
                const float w_t = __shfl(wt, t);
                kT[(2 * lane) * KTS + t] = (bf16_t)f2bf(w_t * bf2f(kb & 0xffffu)); kT[(2 * lane + 1) * KTS + t] = (bf16_t)f2bf(w_t * bf2f(kb >> 16));
            }
        }
    }
    LDS_WAIT(); asm volatile("" ::: "memory");
    {
        const bf16_t* VT = (const bf16_t*)(ws + WS_VT) + (size_t)item * 128 * 64;
        bf16_t* dc = (bf16_t*)(ws + WS_DC) + (size_t)item * 16384;
        for (int nt = 0; nt < 4; ++nt) {
            bf16x8 b[4];
#pragma unroll
            for (int ks = 0; ks < 4; ++ks) b[ks] = *(const bf16x8*)(VT + (unsigned)((ks * 128 + nt * 32 + r) * 16 + 8 * hh));
#pragma unroll
            for (int mt = 0; mt < 4; ++mt) {
                f32x16 acc; for (int i = 0; i < 16; ++i) acc[i] = 0.f;
#pragma unroll
                for (int ks = 0; ks < 4; ++ks) acc = MFMA32(*(const LAS bf16x8*)(kT + (mt * 32 + r) * KTS + ks * 16 + 8 * hh), b[ks], acc);
#pragma unroll
                for (int g4 = 0; g4 < 4; ++g4) { u32x2 w; w.x = pk2(acc[4 * g4], acc[4 * g4 + 1]); w.y = pk2(acc[4 * g4 + 2], acc[4 * g4 + 3]);
                    *(u32x2*)(dc + (unsigned)(((mt * 2 + (g4 >> 1)) * 128 + nt * 32 + r) * 16 + (g4 & 1) * 8 + 4 * hh)) = w; }
            }
        }
        float* NLOC = (float*)(ws + WS_NLOC) + (size_t)item * DH;
#pragma unroll
        for (int half = 0; half < 2; ++half) { const int dk = lane + 64 * half; float s = 0.f;
#pragma unroll
            for (int o = 0; o < 8; ++o) { const u32x4 q = *(const LAS u32x4*)(kT + dk * KTS + 8 * o);
                s += (bf2f(q.x & 0xffffu) + bf2f(q.x >> 16)) + (bf2f(q.y & 0xffffu) + bf2f(q.y >> 16)) + (bf2f(q.z & 0xffffu) + bf2f(q.z >> 16)) + (bf2f(q.w & 0xffffu) + bf2f(q.w >> 16)); }
            NLOC[dk] = s; }
    }
    LDS_WAIT(); asm volatile("" ::: "memory");
}

__device__ __forceinline__ void m2_scans(const Env& A, int l, LAS unsigned char* lds, int tid, int wave, int lane) {
    unsigned char* const ws = A.ws();
    const float* BLAST = (const float*)(ws + WS_BLAST); const float* MAXG = (const float*)(ws + WS_MAXG); float* MST = (float*)(ws + WS_MST);
    const int nb = gridDim.x, nbC = nb >= 2 ? nb / 2 : 1, bid = blockIdx.x;
    if (bid < nbC || nb < 2) {
        const bf16_t* DC = (const bf16_t*)(ws + WS_DC); bf16_t* CST = (bf16_t*)(ws + WS_CST);
        constexpr int NPAIR = NH * 2 * DH * DH / 2;
        for (int it = bid * NTHR + tid; it < NPAIR; it += nbC * NTHR) {
            const int bh = it >> 13, idx = (it & 8191) * 2, b = bh >> 2, h = bh & 3;
            float C0 = 0.f, C1 = 0.f, mp = 0.f;
            for (int c0 = 0; c0 < CPB; c0 += 16) {
                unsigned v[16]; float bl[16], mg[16];
#pragma unroll
                for (int u = 0; u < 16; ++u) { const int item = (b * CPB + c0 + u) * 4 + h; v[u] = *(const unsigned*)(DC + (size_t)item * 16384 + idx); bl[u] = BLAST[item]; mg[u] = MAXG[item]; }
#pragma unroll
                for (int u = 0; u < 16; ++u) {
                    const int item = (b * CPB + c0 + u) * 4 + h;
                    *(unsigned*)(CST + (size_t)item * 16384 + idx) = pk2(C0, C1);
                    if (idx == 0) MST[item] = mp;
                    const float mn = fmaxf(bl[u] + mp, mg[u]);
                    const float d1 = __expf(bl[u] + mp - mn), d2 = __expf(mg[u] - mn);
                    C0 = d1 * C0 + d2 * bf2f(v[u] & 0xffffu); C1 = d1 * C1 + d2 * bf2f(v[u] >> 16); mp = mn;
                }
            }
        }
    }
    if (bid >= nbC || nb < 2) {
        const int ob = nb < 2 ? 0 : bid - nbC, nob = nb < 2 ? 1 : nb - nbC;
        const float* NLOC = (const float*)(ws + WS_NLOC); float* NST = (float*)(ws + WS_NST);
        const float* XLOC = (const float*)(ws + WS_XLOC); bf16_t* XPREV = (bf16_t*)(ws + WS_XPREV); const float* A64 = (const float*)(ws + WS_A64);
        constexpr int NN = NH * 2 * DH, NX = 2 * NG * NS;
        for (int it = ob * NTHR + tid; it < NN + NX; it += nob * NTHR) {
            if (it < NN) {
                const int bh = it >> 7, idx = it & 127, b = bh >> 2, h = bh & 3;
                float Cp = 0.f, mp = 0.f;
                for (int c0 = 0; c0 < CPB; c0 += 16) {
                    float v[16], bl[16], mg[16];
#pragma unroll
                    for (int u = 0; u < 16; ++u) { const int item = (b * CPB + c0 + u) * 4 + h; v[u] = NLOC[(size_t)item * DH + idx]; bl[u] = BLAST[item]; mg[u] = MAXG[item]; }
#pragma unroll
                    for (int u = 0; u < 16; ++u) {
                        const int item = (b * CPB + c0 + u) * 4 + h;
                        NST[(size_t)item * DH + idx] = Cp;
                        const float mn = fmaxf(bl[u] + mp, mg[u]);
                        Cp = __expf(bl[u] + mp - mn) * Cp + __expf(mg[u] - mn) * v[u]; mp = mn;
                    }
                }
            } else {
                const int e = it - NN, b = e >> 11, g = (e >> 6) & 31, n = e & 63;
                const float ar = A64[(g * 64 + n) * 2], ai = A64[(g * 64 + n) * 2 + 1]; float xr = 0.f, xi = 0.f;
                for (int c0 = 0; c0 < CPB; c0 += 16) {
                    float lr[16], li[16];
#pragma unroll
                    for (int u = 0; u < 16; ++u) { const size_t base = ((size_t)(b * CPB + c0 + u) * 32 + g) * 128; lr[u] = XLOC[base + n]; li[u] = XLOC[base + 64 + n]; }
#pragma unroll
                    for (int u = 0; u < 16; ++u) { const size_t base = ((size_t)(b * CPB + c0 + u) * 32 + g) * 128;
                        XPREV[base + n] = (bf16_t)f2bf(xr); XPREV[base + 64 + n] = (bf16_t)f2bf(xi);
                        const float nr = ar * xr - ai * xi + lr[u], ni = ar * xi + ai * xr + li[u]; xr = nr; xi = ni; }
                }
            }
        }
        if (l == 0) {
            const int nscan = (NN + NX + NTHR - 1) / NTHR;
            if (nob > nscan && ob >= nscan) p0_weights(A, 1, lds, wave, lane, (ob - nscan) * NWAVES + wave, (nob - nscan) * NWAVES);
            else if (nob <= nscan) p0_weights(A, 1, lds, wave, lane, ob * NWAVES + wave, nob * NWAVES);
        }
    }
}

constexpr int S5C_KT = 32 * USTR, S5C_XP = S5C_KT + 65 * 512, XPSTR = 256 + 16;
static_assert(S5C_XP + 32 * XPSTR <= RING_BYTES, "S5c LDS");
__device__ __forceinline__ void s5c_item(const Env& A, int l, int g, int rb, LAS unsigned char* lds, int tid, int wave, int lane) {
    unsigned char* const ws = A.ws(); const float* const i10 = A.in(10);
    const unsigned char* U2b = (const unsigned char*)((const bf16_t*)(ws + WS_U2) + ((size_t)g * M + (size_t)rb * 2048) * 16);
    const unsigned char* KTb = (const unsigned char*)((const bf16_t*)(ws + WS_KTAB) + (size_t)g * KTAB_G);
    const bf16_t* XPREV = (const bf16_t*)(ws + WS_XPREV);
    const bf16_t* GT = (const bf16_t*)(ws + WS_GT) + (size_t)g * 1024 * 128;
    bf16_t* Z = (bf16_t*)(ws + WS_Z);
    {
        u32x4 t[8];
#pragma unroll
        for (int i = 0; i < 8; ++i) t[i] = *(const u32x4*)(U2b + (unsigned)((tid + i * NTHR) * 16));
#pragma unroll
        for (int i = 0; i < 8; ++i) { const int idx = tid + i * NTHR; *(LAS u32x4*)(lds + (idx >> 7) * USTR + (idx & 127) * 16) = t[i]; }
        u32x4 k[5]; const u32x4 xp = *(const u32x4*)(XPREV + ((size_t)(rb * 32 + (tid >> 4)) * 32 + g) * 128 + (tid & 15) * 8);
#pragma unroll
        for (int i = 0; i < 5; ++i) { const int idx = tid + i * NTHR; k[i] = idx < 2080 ? *(const u32x4*)(KTb + (unsigned)(idx * 16)) : (u32x4){0u, 0u, 0u, 0u}; }
#pragma unroll
        for (int i = 0; i < 5; ++i) { const int idx = tid + i * NTHR; if (idx < 2080) *(LAS u32x4*)(lds + S5C_KT + idx * 16) = k[i]; }
        *(LAS u32x4*)(lds + S5C_XP + (tid >> 4) * XPSTR + (tid & 15) * 16) = xp;
    }
    __syncthreads();
    const int r = lane & 31, hh = lane >> 5, tsub = r >> 4, p = r & 15;
    int tt[4]; tt[0] = wave; tt[1] = 15 - wave; tt[2] = 16 + wave; tt[3] = 31 - wave;
    f32x16 acc[4];
#pragma unroll
    for (int j = 0; j < 4; ++j) for (int i = 0; i < 16; ++i) acc[j][i] = 0.f;
    const LAS unsigned char* ua = lds + r * USTR + hh * 16;
    const LAS unsigned char* kb = lds + S5C_KT + p * 32 + hh * 16;
#pragma unroll 2
    for (int s = 0; s < 64; ++s) {
        const bf16x8 u = *(const LAS bf16x8*)(ua + s * 32);
#pragma unroll
        for (int j = 0; j < 4; ++j) if (s <= 2 * tt[j] + 1) { const int tau1 = 2 * tt[j] + tsub - s + 1; const bf16x8 k = *(const LAS bf16x8*)(kb + tau1 * 512); acc[j] = MFMA32(k, u, acc[j]); }
    }
    const LAS unsigned char* xa = lds + S5C_XP + r * XPSTR + hh * 16;
#pragma unroll
    for (int ks = 0; ks < 8; ++ks) {
        const bf16x8 x = *(const LAS bf16x8*)(xa + ks * 32);
#pragma unroll
        for (int j = 0; j < 4; ++j) { const bf16x8 gfr = *(const bf16x8*)(GT + (unsigned)((ks * 1024 + tt[j] * 32 + r) * 16 + 8 * hh)); acc[j] = MFMA32(gfr, x, acc[j]); }
    }
#pragma unroll
    for (int j = 0; j < 4; ++j) {
#pragma unroll
        for (int g4 = 0; g4 < 4; ++g4) {
            const int t = 2 * tt[j] + (g4 >> 1), p0 = 8 * (g4 & 1) + 4 * hh;
            const f32x4 dd = *(const f32x4*)(i10 + (l * NG + g) * 16 + p0);
            const u32x2 uv = *(const LAS u32x2*)(lds + r * USTR + (t * 16 + p0) * 2);
            const float y0 = acc[j][4 * g4] + dd.x * bf2f(uv.x & 0xffffu), y1 = acc[j][4 * g4 + 1] + dd.y * bf2f(uv.x >> 16), y2 = acc[j][4 * g4 + 2] + dd.z * bf2f(uv.y & 0xffffu), y3 = acc[j][4 * g4 + 3] + dd.w * bf2f(uv.y >> 16);
            u32x2 o; o.x = pk2(gelu_tanh(y0), gelu_tanh(y1)); o.y = pk2(gelu_tanh(y2), gelu_tanh(y3));
            *(u32x2*)(Z + (unsigned)(((rb * 32 + r) * 64 + t) * 512 + g * 16 + p0)) = o;
        }
    }
    __syncthreads();
}
constexpr int PSTR = 72, MLC_LDS = 8192;
__device__ __forceinline__ void mlc_wave(const Env& A, int l, int item, int mt, LAS unsigned char* wl, int lane_in) {
    int lane = lane_in; asm volatile("" : "+v"(lane)); __builtin_assume(lane >= 0 && lane < 64);
    unsigned char* const ws = A.ws(); const float* const i18 = A.in(18);
    const int cid = item >> 2, h = item & 3, row0 = cid * 64 + mt * 32, r = lane & 31, hh = lane >> 5;
    const bf16_t* QC = (const bf16_t*)(ws + WS_QC) + (size_t)item * 8192;
    const bf16_t* KC = (const bf16_t*)(ws + WS_KC) + (size_t)item * 8192;
    const bf16_t* VT = (const bf16_t*)(ws + WS_VT) + (size_t)item * 128 * 64;
    const bf16_t* CST = (const bf16_t*)(ws + WS_CST) + (size_t)item * 16384;
    const bf16_t* ORAW = (const bf16_t*)(ws + WS_ORAW) + (size_t)(row0 + r) * 512 + h * DH;
    bf16_t* YCAT = (bf16_t*)(ws + WS_YCAT) + (size_t)(row0 + r) * 1024 + 512 + h * DH;
    LAS bf16_t* P = (LAS bf16_t*)wl;
    LAS float* al = (LAS float*)(wl + 4608);
    const float mst = ((const float*)(ws + WS_MST))[item];
    al[lane] = ((const float*)(ws + WS_AARR))[item * 64 + lane];
    const int tl = mt * 32 + r;
    const float Mt = fmaxf(mst, ((const float*)(ws + WS_PMAX))[item * 64 + tl]);
    const float sc_t = __expf(mst - Mt), emt_t = __expf(-((const float*)(ws + WS_BCUM))[item * 64 + tl] - Mt);
    bf16x8 qf[8];
#pragma unroll
    for (int ks = 0; ks < 8; ++ks) qf[ks] = *(const bf16x8*)(QC + (unsigned)((ks * 64 + mt * 32 + r) * 16 + 8 * hh));
    LDS_WAIT(); asm volatile("" ::: "memory");
    f32x16 accQ[4];
#pragma unroll
    for (int i = 0; i < 16; ++i) { accQ[0][i] = 0.f; accQ[1][i] = 0.f; accQ[2][i] = 0.f; accQ[3][i] = 0.f; }
#pragma unroll
    for (int nt = 0; nt < 4; ++nt) {
        bf16x8 b[8];
#pragma unroll
        for (int ks = 0; ks < 8; ++ks) b[ks] = *(const bf16x8*)(CST + (unsigned)((ks * 128 + nt * 32 + r) * 16 + 8 * hh));
#pragma unroll
        for (int ks = 0; ks < 8; ++ks) accQ[nt] = MFMA32(b[ks], qf[ks], accQ[nt]);
        asm volatile("" ::: "memory");
    }
    float den2;
    {
        const float* NST = (const float*)(ws + WS_NST) + (size_t)item * DH; float s = 0.f;
#pragma unroll
        for (int ks = 0; ks < 8; ++ks) { const f32x4 n0 = *(const f32x4*)(NST + ks * 16 + 8 * hh), n1 = *(const f32x4*)(NST + ks * 16 + 8 * hh + 4);
            s += bf2f((unsigned short)qf[ks][0]) * n0.x + bf2f((unsigned short)qf[ks][1]) * n0.y + bf2f((unsigned short)qf[ks][2]) * n0.z + bf2f((unsigned short)qf[ks][3]) * n0.w
               + bf2f((unsigned short)qf[ks][4]) * n1.x + bf2f((unsigned short)qf[ks][5]) * n1.y + bf2f((unsigned short)qf[ks][6]) * n1.z + bf2f((unsigned short)qf[ks][7]) * n1.w; }
        auto q2 = __builtin_amdgcn_permlane32_swap(__float_as_uint(s), __float_as_uint(s), false, false); den2 = __uint_as_float(q2[0]) + __uint_as_float(q2[1]);
    }
    float rsum = 0.f;
    for (int st = 0; st <= mt; ++st) {
        f32x16 accS; for (int i = 0; i < 16; ++i) accS[i] = 0.f;
        {   bf16x8 b[8];
#pragma unroll
            for (int ks = 0; ks < 8; ++ks) b[ks] = *(const bf16x8*)(KC + (unsigned)((ks * 64 + st * 32 + r) * 16 + 8 * hh));
#pragma unroll
            for (int ks = 0; ks < 8; ++ks) accS = MFMA32(b[ks], qf[ks], accS);
            asm volatile("" ::: "memory"); }
#pragma unroll
        for (int g4 = 0; g4 < 4; ++g4) {
            float pv[4];
#pragma unroll
            for (int e = 0; e < 4; ++e) { const int s = st * 32 + 8 * g4 + 4 * hh + e; const float w = (s <= tl) ? __expf(al[s] - Mt) : 0.f; pv[e] = accS[4 * g4 + e] * w; rsum += pv[e]; }
            u32x2 o; o.x = pk2(pv[0], pv[1]); o.y = pk2(pv[2], pv[3]);
            *(LAS u32x2*)(P + r * PSTR + st * 32 + 8 * g4 + 4 * hh) = o;
        }
    }
    { auto q = __builtin_amdgcn_permlane32_swap(__float_as_uint(rsum), __float_as_uint(rsum), false, false); rsum = __uint_as_float(q[0]) + __uint_as_float(q[1]); }
    const float inv_t = 1.0f / fmaxf(fabsf(rsum + sc_t * den2), emt_t);
#pragma unroll
    for (int nt = 0; nt < 4; ++nt)
#pragma unroll
        for (int reg = 0; reg < 16; ++reg) accQ[nt][reg] *= sc_t;
    LDS_WAIT(); asm volatile("" ::: "memory");
    const int nks = 2 * (mt + 1);
#pragma unroll 1
    for (int ks = 0; ks < nks; ++ks) {
        const bf16x8 pb = *(const LAS bf16x8*)(P + r * PSTR + ks * 16 + 8 * hh);
        bf16x8 a[4];
#pragma unroll
        for (int nt = 0; nt < 4; ++nt) a[nt] = *(const bf16x8*)(VT + (unsigned)((ks * 128 + nt * 32 + r) * 16 + 8 * hh));
#pragma unroll
        for (int nt = 0; nt < 4; ++nt) accQ[nt] = MFMA32(a[nt], pb, accQ[nt]);
        asm volatile("" ::: "memory");
    }
    float sq = 0.f;
#pragma unroll
    for (int nt = 0; nt < 4; ++nt) {
        u32x2 ov[4];
#pragma unroll
        for (int g4 = 0; g4 < 4; ++g4) ov[g4] = *(const u32x2*)(ORAW + (unsigned)(nt * 32 + 8 * g4 + 4 * hh));
#pragma unroll
        for (int g4 = 0; g4 < 4; ++g4) {
            const float o0 = sigmoid_f(bf2f(ov[g4].x & 0xffffu)), o1 = sigmoid_f(bf2f(ov[g4].x >> 16)), o2 = sigmoid_f(bf2f(ov[g4].y & 0xffffu)), o3 = sigmoid_f(bf2f(ov[g4].y >> 16));
            const float h0 = o0 * accQ[nt][4 * g4] * inv_t, h1 = o1 * accQ[nt][4 * g4 + 1] * inv_t, h2 = o2 * accQ[nt][4 * g4 + 2] * inv_t, h3 = o3 * accQ[nt][4 * g4 + 3] * inv_t;
            accQ[nt][4 * g4] = h0; accQ[nt][4 * g4 + 1] = h1; accQ[nt][4 * g4 + 2] = h2; accQ[nt][4 * g4 + 3] = h3;
            sq += (h0 * h0 + h1 * h1) + (h2 * h2 + h3 * h3);
        }
    }
    { auto q = __builtin_amdgcn_permlane32_swap(__float_as_uint(sq), __float_as_uint(sq), false, false); sq = __uint_as_float(q[0]) + __uint_as_float(q[1]); }
    const float rsn = rsqrtf(sq * (1.0f / DH) + EPS);
    const float* gg = i18 + l * 512 + h * DH;
#pragma unroll
    for (int nt = 0; nt < 4; ++nt)
#pragma unroll
        for (int g4 = 0; g4 < 4; ++g4) {
            const f32x4 gv = *(const f32x4*)(gg + nt * 32 + 8 * g4 + 4 * hh);
            u32x2 o; o.x = pk2(accQ[nt][4 * g4] * rsn * gv.x, accQ[nt][4 * g4 + 1] * rsn * gv.y); o.y = pk2(accQ[nt][4 * g4 + 2] * rsn * gv.z, accQ[nt][4 * g4 + 3] * rsn * gv.w);
            *(u32x2*)(YCAT + (unsigned)(nt * 32 + 8 * g4 + 4 * hh)) = o;
        }
    LDS_WAIT(); asm volatile("" ::: "memory");
}
__device__ __forceinline__ void final_norm(const Env& A, int wave, int lane) {
    const int gw = blockIdx.x * NWAVES + wave, NGW = gridDim.x * NWAVES;
    unsigned char* const ws = A.ws();
    const float* slots = (const float*)(ws + WS_SLOTS); const bf16_t* XB = (const bf16_t*)(ws + WS_XB); float* const xo = A.out();
    const f32x4 g0 = *((const f32x4*)A.in(23) + 2 * lane), g1 = *((const f32x4*)A.in(23) + 2 * lane + 1), g2 = *((const f32x4*)A.in(23) + 128 + 2 * lane), g3 = *((const f32x4*)A.in(23) + 128 + 2 * lane + 1);
    for (int m = gw; m < M; m += NGW) {
        const float rs = rsqrtf(sum16(slots + (size_t)m * 16) * (1.0f / D) + EPS);
        const u32x4 a = *((const u32x4*)(XB + (size_t)m * D) + lane), b = *((const u32x4*)(XB + (size_t)m * D) + 64 + lane);
        f32x4* o = (f32x4*)(xo + (size_t)m * D);
        o[2 * lane] = (f32x4){bf2f(a.x & 0xffffu), bf2f(a.x >> 16), bf2f(a.y & 0xffffu), bf2f(a.y >> 16)} * rs * g0;
        o[2 * lane + 1] = (f32x4){bf2f(a.z & 0xffffu), bf2f(a.z >> 16), bf2f(a.w & 0xffffu), bf2f(a.w >> 16)} * rs * g1;
        o[128 + 2 * lane] = (f32x4){bf2f(b.x & 0xffffu), bf2f(b.x >> 16), bf2f(b.y & 0xffffu), bf2f(b.y >> 16)} * rs * g2;
        o[128 + 2 * lane + 1] = (f32x4){bf2f(b.z & 0xffffu), bf2f(b.z >> 16), bf2f(b.w & 0xffffu), bf2f(b.w >> 16)} * rs * g3;
    }
}

constexpr int N_PHASES = 18;
#ifndef MK_PHMASK
#define MK_PHMASK 0x3ff
#endif
#define PHEN(i) (((MK_PHMASK) >> (i)) & 1)
__global__ void __launch_bounds__(NTHR, 2) mega_fwd(Args args) {
    extern __shared__ __attribute__((aligned(16))) unsigned char lds_raw[];
    LAS unsigned char* lds = (LAS unsigned char*)lds_raw;
    volatile LAS unsigned* MISC = (volatile LAS unsigned*)(lds + MISC_OFF);
    volatile LAS unsigned* PT = (volatile LAS unsigned*)(lds + MISC_OFF - 256);
    if (threadIdx.x < 64) MISC[threadIdx.x] = 0u;
    if (threadIdx.x == 0) {
#pragma unroll
        for (int i = 0; i < 24; ++i) { const unsigned long long v = (unsigned long long)args.in[i]; PT[2 * i] = (unsigned)v; PT[2 * i + 1] = (unsigned)(v >> 32); }
        { const unsigned long long v = (unsigned long long)args.out; PT[48] = (unsigned)v; PT[49] = (unsigned)(v >> 32); }
        { const unsigned long long v = (unsigned long long)args.ws; PT[50] = (unsigned)v; PT[51] = (unsigned)(v >> 32); }
    }
    __syncthreads();
    Env A; A.pt = PT;
    const int wave0 = __builtin_amdgcn_readfirstlane(threadIdx.x >> 6);
    XcdBarrier bar = xcd_barrier_post((unsigned*)(args.ws + WS_CTL) + CW_BAR, MISC + 8);
    const int lo = args.ph_lo, hi = args.ph_hi, flags = args.flags;
#ifndef MK_REP_PH
#define MK_REP_PH -1
#endif
#ifndef MK_REP_SUB
#define MK_REP_SUB 0
#endif
#define SUBREP(code) for (int rep_ = 0; rep_ < ((MK_REP_SUB) == (code) ? 2 : 1); ++rep_)
    for (int ph = lo, rep = 0; ph < hi; (ph == MK_REP_PH && rep == 0) ? (rep = 1) : (rep = 0, ++ph)) {
        int wave = wave0; asm volatile("" : "+s"(wave));
        int lane; asm volatile("v_mbcnt_lo_u32_b32 %0, -1, 0\n\tv_mbcnt_hi_u32_b32 %0, -1, %0" : "=v"(lane));
        __builtin_assume(lane >= 0 && lane < 64); __builtin_assume(wave >= 0 && wave < 8);
        const int tid = wave * 64 + lane;
        if (ph > lo || rep) xcd_barrier(bar, (unsigned*)(A.ws() + WS_CTL) + CW_BAR, tid == 0);
        if (ph == 0) { if (PHEN(0)) {
            SUBREP(6) p0_weights(A, 0, lds, wave, lane, blockIdx.x * NWAVES + wave, gridDim.x * NWAVES);
            SUBREP(7) rpass(A.in(0), (bf16_t*)A.out(), A.ws(), wave, lane);
            __syncthreads();
            SUBREP(8) for (int it = blockIdx.x; it < 256; it += gridDim.x) build_tables(A, 0, it >> 3, it & 7, lds, tid); }
        } else if (ph == 17) {
            if (PHEN(9)) final_norm(A, wave, lane);
        } else {
            const int l = (ph - 1) >> 3, k = (ph - 1) & 7;
            unsigned char* const ws = A.ws();
            if (k == 1) { if (PHEN(2)) {
                SUBREP(1) for (int it = blockIdx.x; it < 256; it += gridDim.x) s5a_item(ws, it & 31, it >> 5, lds, tid, wave, lane);
                if ((wave & 1) == 0) SUBREP(2) for (int it = blockIdx.x * 4 + (wave >> 1); it < NITEM; it += gridDim.x * 4) mla_wave(A, l, it >> 2, it & 3, lds + wave * MLA_LDS, lane); }
            } else if (k == 2) {
                if (PHEN(3)) m2_scans(A, l, lds, tid, wave, lane);
            } else if (k == 3) { if (PHEN(4)) {
                SUBREP(3) for (int it = blockIdx.x; it < 256; it += gridDim.x) s5c_item(A, l, it & 31, it >> 5, lds, tid, wave, lane);
                SUBREP(4) for (int it = blockIdx.x * NWAVES + wave; it < 2 * NITEM; it += gridDim.x * NWAVES) mlc_wave(A, l, it >> 1, it & 1, lds + wave * MLC_LDS, lane); }
            } else {
#define LAUNDER_TD() int wv = wave0; asm volatile("" : "+s"(wv)); int ln; asm volatile("v_mbcnt_lo_u32_b32 %0, -1, 0\n\tv_mbcnt_hi_u32_b32 %0, -1, %0" : "=v"(ln)); __builtin_assume(ln >= 0 && ln < 64); __builtin_assume(wv >= 0 && wv < 8); const int td = wv * 64 + ln
                unsigned char* const wb = ws + WS_W + (size_t)l * W_LSTRIDE;
                if (k == 0) { if (PHEN(1)) {
                    pg8::Gemm g{(const bf16_t*)A.out(), (const bf16_t*)(wb + OFF_WIN), M, NP, D}; pg8::StaticOrder S; S.init(M, NP, gridDim.x, blockIdx.x);
                    EpiK<1> E{ws, nullptr, nullptr}; LAUNDER_TD();
                    pg8::gemm_phase<EpiK<1>, pg8::StaticOrder, true, true>(lds, g, S, E, td);
                    {
                        const int G_ = gridDim.x, rem = (M / 256 * (NP / 256)) % G_, first = rem == 0 ? 0 : rem, nb_ = G_ - first;
                        SUBREP(9) if ((int)blockIdx.x >= first) gates_wave(ws, (const bf16_t*)A.out(), l, ((int)blockIdx.x - first) * NWAVES + wave, M / 8, nb_ * NWAVES, lane);
                    } }
                } else if (k == 4) { if (PHEN(5)) {
                    pg8::Gemm g{(const bf16_t*)(ws + WS_Z), (const bf16_t*)(wb + OFF_WGLU), M, DS, DS}; pg8::StaticOrder S; S.init(M, DS, gridDim.x, blockIdx.x);
                    EpiK<2> E{ws, A.in(12) + l * DS, nullptr}; LAUNDER_TD();
                    pg8::gemm_phase<EpiK<2>, pg8::StaticOrder, true, true>(lds, g, S, E, td);
                    if (l == 0) {
                        __syncthreads();
                        const int nfree = (int)gridDim.x > 128 ? (int)gridDim.x - 128 : (int)gridDim.x, first = (int)gridDim.x > 128 ? 128 : 0;
                        SUBREP(5) if ((int)blockIdx.x >= first) for (int it = blockIdx.x - first; it < 256; it += nfree) build_tables(A, 1, it >> 3, it & 7, lds, tid);
                    } }
                } else if (k == 5) { if (PHEN(6)) {
                    pg8::Gemm g{(const bf16_t*)(ws + WS_YCAT), (const bf16_t*)(wb + OFF_WOUT), M, D, D}; pg8::StaticOrder S; S.init(M, D, gridDim.x, blockIdx.x);
                    void* const xo = (void*)A.out();
                    EpiK<3> E{ws, xo, xo}; LAUNDER_TD();
                    pg8::gemm_phase<EpiK<3>, pg8::StaticOrder, true, true>(lds, g, S, E, td); }
                } else if (k == 6) { if (PHEN(7)) {
                    pg8::Gemm g{(const bf16_t*)A.out(), (const bf16_t*)(wb + OFF_W1), M, DFF, D}; pg8::StaticOrder S; S.init(M, DFF, gridDim.x, blockIdx.x);
                    EpiK<4> E{ws, nullptr, nullptr}; LAUNDER_TD();
                    pg8::gemm_phase<EpiK<4>, pg8::StaticOrder, true, true>(lds, g, S, E, td); }
                } else { if (PHEN(8)) {
                    pg8::Gemm g{(const bf16_t*)(ws + WS_H1), (const bf16_t*)(wb + OFF_W2), M, D, DFF}; pg8::StaticOrder S; S.init(M, D, gridDim.x, blockIdx.x);
                    void* const xo = (void*)A.out();
                    EpiK<5> E{ws, xo, l == 1 ? (void*)(ws + WS_XB) : xo}; LAUNDER_TD();
                    pg8::gemm_phase<EpiK<5>, pg8::StaticOrder, true, true>(lds, g, S, E, td); }
                }
            }
        }
    }
}

extern "C" void kernel_launch(void* const* d_in, const int* in_sizes, int n_in, void* d_out, int out_size, void* d_ws, size_t ws_size, hipStream_t stream) {
    static int grid = 0;
    if (grid == 0) {
        if (n_in != 24 || out_size != M * D || ws_size < WS_END) { fprintf(stderr, "kernel_launch: unexpected problem shape (n_in %d out %d ws %zu)\n", n_in, out_size, ws_size); grid = -1; return; }
        int dev = 0, cus = 0, per_cu = 0;
        if (hipGetDevice(&dev) != hipSuccess || hipDeviceGetAttribute(&cus, hipDeviceAttributeMultiprocessorCount, dev) != hipSuccess) { grid = -1; return; }
        if (hipFuncSetAttribute((const void*)mega_fwd, hipFuncAttributeMaxDynamicSharedMemorySize, LDS_BYTES) != hipSuccess) { fprintf(stderr, "kernel_launch: hipFuncSetAttribute failed\n"); grid = -1; return; }
        if (hipOccupancyMaxActiveBlocksPerMultiprocessor(&per_cu, (const void*)mega_fwd, NTHR, LDS_BYTES) != hipSuccess || per_cu < 1) { fprintf(stderr, "kernel_launch: occupancy query says %d\n", per_cu); per_cu = 1; }
        (void)hipGetLastError();
        grid = cus;
    }
    if (grid < 0) return;
    (void)hipMemsetAsync((char*)d_ws + WS_CTL, 0, CTL_ZERO_BYTES, stream);
    Args a{};
    for (int i = 0; i < 24; ++i) a.in[i] = (const float*)d_in[i];
    a.out = (float*)d_out; a.ws = (unsigned char*)d_ws; a.flags = 0; a.pad = 0;
#ifndef MK_SPLIT
    a.ph_lo = 0; a.ph_hi = N_PHASES;
    hipLaunchKernelGGL(mega_fwd, dim3(grid), dim3(NTHR), LDS_BYTES, stream, a);
#else
    for (int ph = 0; ph < N_PHASES; ++ph) { a.ph_lo = ph; a.ph_hi = ph + 1; hipLaunchKernelGGL(mega_fwd, dim3(grid), dim3(NTHR), LDS_BYTES, stream, a); }
#endif
}
```

```cpp
#include <hip/hip_runtime.h>
#include <cstdio>
#include <cstdint>
namespace pg8 {
#define PG8_LAS __attribute__((address_space(3)))
typedef unsigned short bf16_t;
typedef short bf16x8 __attribute__((ext_vector_type(8)));
typedef float f32x4 __attribute__((ext_vector_type(4)));
typedef unsigned u32x4 __attribute__((ext_vector_type(4)));
constexpr int BM = 256, BK = 64, HALF = 128, HTB = HALF * BK * 2  , STAGE_BYTES = 8 * HTB, NXCD = 8, WGM = 8;

__host__ __device__ __forceinline__ int lds_byte(int r, int c) { const int st = (r >> 4) * 2 + (c >> 5), rr = r & 15, cc = c & 31, ob = rr * 64 + cc * 2; return st * 1024 + (ob ^ (((ob >> 9) & 1) << 5)); }
__host__ __device__ __forceinline__ void stage_rc(int b, int& R, int& C) { const int st = b / 1024, sb = b % 1024, swz = sb ^ (((sb >> 9) & 1) << 5); R = (st >> 1) * 16 + swz / 64; C = (st & 1) * 32 + (swz % 64) / 2; }
__host__ __device__ __forceinline__ int perm32(int rho) { const int n = rho >> 4, i = rho & 15; return 8 * (i >> 2) + 4 * n + (i & 3); }

struct Unit { int pm, pn; };
struct Gemm { const bf16_t* A; const bf16_t* Bt; int M, N, K; };

struct StaticOrder {
    int nM, nN, nwg, G, c;
    __host__ __device__ void init(int M, int N, int G_, int c_) { nM = M / BM; nN = N / BM; nwg = nM * nN; G = G_; c = c_; }
    __host__ __device__ bool next(int i, Unit& u) const {
        const long L = (long)i * G + c; if (L >= nwg) return false;
        int wgid = (int)L; { const int q = nwg / NXCD, r = nwg % NXCD, xcd = wgid % NXCD, off = wgid / NXCD; wgid = (xcd < r ? xcd * (q + 1) : r * (q + 1) + (xcd - r) * q) + off; }
        const int nig = WGM * nN, gid = wgid / nig, fm = gid * WGM, gsz = (nM - fm) < WGM ? (nM - fm) : WGM;
        u.pm = fm + ((wgid % nig) % gsz); u.pn = (wgid % nig) / gsz; return true;
    }
    __device__ __forceinline__ void a_ready(const Unit&) const {}
    __device__ __forceinline__ void done(const Unit&) const {}
};
__device__ __forceinline__ unsigned cvt_pk_bf16(float lo, float hi) { unsigned r; asm volatile("v_cvt_pk_bf16_f32 %0, %1, %2" : "=v"(r) : "v"(lo), "v"(hi)); return r; }

template <class Epi, class Sched, bool ALIGN_EPI = false, bool SP2 = false>
__device__ __forceinline__ void gemm_phase(PG8_LAS unsigned char* lds, const Gemm g, const Sched& S, const Epi& E, const int tid) {
    const int wid = __builtin_amdgcn_readfirstlane(tid >> 6), lane = tid & 63, wr = wid >> 2, wc = wid & 3, fr = lane & 15, fq = lane >> 4;
    const int K = g.K, nt = K / BK;
    unsigned voffA[2], voffB[2];
#pragma unroll
    for (int i = 0; i < 2; ++i) { int R, C; stage_rc(tid * 16 + i * 8192, R, C); const int Rb = E.perm() ? ((R & ~31) + perm32(R & 31)) : R;
        voffA[i] = (unsigned)(R * K + C) * 2u; voffB[i] = (unsigned)(Rb * K + C) * 2u; }
    const size_t kstep = (size_t)(BK * 2);
    const size_t hstep = (size_t)HALF * K * 2;
    const size_t tstep = 2 * hstep;
    const unsigned ldsw = (unsigned)wid * 1024u;
    const int aoff = lds_byte(wr * 64 + fr, fq * 8), boff = lds_byte(wc * 32 + fr, fq * 8);
#define PG8_SA(b, h) (((b) * 2 + (h)) * HTB)
#define PG8_SB(b, h) ((4 + (b) * 2 + (h)) * HTB)
#define PG8_STAGE(bufoff, gbase, voff) do { _Pragma("unroll") for (int _i = 0; _i < 2; ++_i) \
        __builtin_amdgcn_global_load_lds((const unsigned*)((const char*)(gbase) + (voff)[_i]), (PG8_LAS unsigned*)(lds + (bufoff) + ldsw + _i * 8192), 16, 0, 0); } while (0)
#define PG8_LDA(dst, b, h) do { _Pragma("unroll") for (int m = 0; m < 4; ++m) _Pragma("unroll") for (int k = 0; k < 2; ++k) dst[m][k] = *(const PG8_LAS bf16x8*)(lds + PG8_SA(b, h) + aoff + m * 2048 + k * 1024); } while (0)
#define PG8_LDB(dst, b, h) do { _Pragma("unroll") for (int n = 0; n < 2; ++n) _Pragma("unroll") for (int k = 0; k < 2; ++k) dst[n][k] = *(const PG8_LAS bf16x8*)(lds + PG8_SB(b, h) + boff + n * 2048 + k * 1024); } while (0)
#define PG8_MMA(ai, bj, At, Bt) do { __builtin_amdgcn_s_setprio(1); _Pragma("unroll") for (int m = 0; m < 4; ++m) _Pragma("unroll") for (int n = 0; n < 2; ++n) _Pragma("unroll") for (int k = 0; k < 2; ++k) \
        acc[ai][bj][m][n] = __builtin_amdgcn_mfma_f32_16x16x32_bf16(Bt[n][k], At[m][k], acc[ai][bj][m][n], 0, 0, 0); __builtin_amdgcn_s_setprio(0); } while (0)
#define PG8_WAIT_V(n) asm volatile("s_waitcnt vmcnt(" #n ")" ::: "memory")
#define PG8_WAIT_L(n) asm volatile("s_waitcnt lgkmcnt(" #n ")" ::: "memory")
#define PG8_BAR __builtin_amdgcn_s_barrier()
#define PG8_SCHED __builtin_amdgcn_sched_barrier(0)
    Unit cur, nxt; int ui = 0;
    if (!S.next(0, cur)) return;
    f32x4 acc[2][2][4][2];
#pragma unroll
    for (int a = 0; a < 2; ++a)
#pragma unroll
        for (int b = 0; b < 2; ++b)
#pragma unroll
            for (int m = 0; m < 4; ++m)
#pragma unroll
                for (int n = 0; n < 2; ++n) acc[a][b][m][n] = (f32x4){0.f, 0.f, 0.f, 0.f};
    bf16x8 At[4][2], B0[2][2], B1[2][2];
    const char* cA = (const char*)g.A + (size_t)cur.pm * tstep; const char* cB = (const char*)g.Bt + (size_t)cur.pn * tstep;
    S.a_ready(cur);
    E.prep(cur, wr, lane);
    if constexpr (SP2) {
        PG8_STAGE(PG8_SB(0, 0), cB, voffB); PG8_STAGE(PG8_SB(0, 1), cB + hstep, voffB); PG8_STAGE(PG8_SA(0, 0), cA, voffA); PG8_STAGE(PG8_SA(0, 1), cA + hstep, voffA);
        if (wr == 1) PG8_BAR;
        PG8_WAIT_V(2); PG8_BAR;
        PG8_STAGE(PG8_SB(1, 0), cB + kstep, voffB); PG8_STAGE(PG8_SA(1, 0), cA + kstep, voffA); PG8_STAGE(PG8_SB(1, 1), cB + hstep + kstep, voffB);
        PG8_WAIT_V(6); PG8_BAR;
    } else {
        PG8_STAGE(PG8_SB(0, 0), cB, voffB); PG8_STAGE(PG8_SA(0, 0), cA, voffA); PG8_STAGE(PG8_SB(0, 1), cB + hstep, voffB); PG8_STAGE(PG8_SA(0, 1), cA + hstep, voffA);
        if (wr == 1) PG8_BAR;
        PG8_WAIT_V(4); PG8_BAR;
        PG8_STAGE(PG8_SB(1, 0), cB + kstep, voffB); PG8_STAGE(PG8_SA(1, 0), cA + kstep, voffA); PG8_STAGE(PG8_SB(1, 1), cB + hstep + kstep, voffB);
        PG8_WAIT_V(6); PG8_BAR;
    }
    for (;;) {
        const bool has_next = S.next(ui + 1, nxt);
        const char* nA = has_next ? (const char*)g.A + (size_t)nxt.pm * tstep : cA; const char* nB = has_next ? (const char*)g.Bt + (size_t)nxt.pn * tstep : cB;
        for (int t = 0; t < nt; t += 2) {
            const bool last = (t == nt - 2);
            const char* a1 = cA + (size_t)(t + 1) * kstep;
            const char* a2 = last ? nA : cA + (size_t)(t + 2) * kstep; const char* b2 = last ? nB : cB + (size_t)(t + 2) * kstep;
            const char* a3 = a2 + kstep; const char* b3 = b2 + kstep;
            if (last && has_next) S.a_ready(nxt);
            if (t == E.mid_t()) E.mid(acc, cur, wr, wc, fr, fq);
            if constexpr (SP2) {
            PG8_LDB(B0, 0, 0); PG8_LDB(B1, 0, 1); PG8_SCHED; PG8_LDA(At, 0, 0); PG8_STAGE(PG8_SA(1, 1), a1 + hstep, voffA);
            PG8_WAIT_V(8); PG8_WAIT_L(0); PG8_BAR; PG8_MMA(0, 0, At, B0); PG8_MMA(0, 1, At, B1); PG8_BAR; PG8_SCHED;
            PG8_LDA(At, 0, 1); PG8_STAGE(PG8_SB(0, 0), b2, voffB); PG8_STAGE(PG8_SB(0, 1), b2 + hstep, voffB); PG8_STAGE(PG8_SA(0, 0), a2, voffA);
            PG8_WAIT_V(8); PG8_WAIT_L(0); PG8_BAR; PG8_MMA(1, 0, At, B0); PG8_MMA(1, 1, At, B1); PG8_BAR; PG8_SCHED;
            PG8_LDB(B0, 1, 0); PG8_LDB(B1, 1, 1); PG8_SCHED; PG8_LDA(At, 1, 0); PG8_STAGE(PG8_SA(0, 1), a2 + hstep, voffA);
            PG8_WAIT_V(8); PG8_WAIT_L(0); PG8_BAR; PG8_MMA(0, 0, At, B0); PG8_MMA(0, 1, At, B1); PG8_BAR; PG8_SCHED;
            PG8_LDA(At, 1, 1); PG8_STAGE(PG8_SB(1, 0), b3, voffB); PG8_STAGE(PG8_SB(1, 1), b3 + hstep, voffB); PG8_STAGE(PG8_SA(1, 0), a3, voffA);
            PG8_WAIT_V(8); PG8_WAIT_L(0); PG8_BAR; PG8_MMA(1, 0, At, B0); PG8_MMA(1, 1, At, B1); PG8_BAR; PG8_SCHED;
            } else {
            PG8_LDB(B0, 0, 0); PG8_SCHED; PG8_LDA(At, 0, 0); PG8_STAGE(PG8_SA(1, 1), a1 + hstep, voffA);
            PG8_WAIT_L(8); PG8_BAR; PG8_WAIT_L(0); PG8_MMA(0, 0, At, B0); PG8_BAR; PG8_SCHED;
            PG8_LDB(B1, 0, 1); PG8_STAGE(PG8_SB(0, 0), b2, voffB);
            PG8_BAR; PG8_WAIT_L(0); PG8_MMA(0, 1, At, B1); PG8_BAR;
            PG8_LDA(At, 0, 1); PG8_STAGE(PG8_SA(0, 0), a2, voffA);
            PG8_BAR; PG8_WAIT_L(0); PG8_MMA(1, 0, At, B0); PG8_BAR; PG8_SCHED;
            PG8_STAGE(PG8_SB(0, 1), b2 + hstep, voffB);
            PG8_WAIT_V(6); PG8_BAR; PG8_MMA(1, 1, At, B1); PG8_BAR;
            PG8_LDB(B0, 1, 0); PG8_SCHED; PG8_LDA(At, 1, 0); PG8_STAGE(PG8_SA(0, 1), a2 + hstep, voffA);
            PG8_WAIT_L(8); PG8_BAR; PG8_WAIT_L(0); PG8_MMA(0, 0, At, B0); PG8_BAR; PG8_SCHED;
            PG8_LDB(B1, 1, 1); PG8_STAGE(PG8_SB(1, 0), b3, voffB);
            PG8_BAR; PG8_WAIT_L(0); PG8_MMA(0, 1, At, B1); PG8_BAR;
            PG8_LDA(At, 1, 1); PG8_STAGE(PG8_SA(1, 0), a3, voffA);
            PG8_BAR; PG8_WAIT_L(0); PG8_MMA(1, 0, At, B0); PG8_BAR; PG8_SCHED;
            PG8_STAGE(PG8_SB(1, 1), b3 + hstep, voffB);
            PG8_WAIT_V(6); PG8_BAR; PG8_MMA(1, 1, At, B1); PG8_BAR;
            }
        }
        if constexpr (ALIGN_EPI) { if (wr == 0) PG8_BAR; }
        if constexpr (!Epi::AFTER_DRAIN) { E(acc, cur, wr, wc, fr, fq); S.done(cur); }
        if (!has_next) break;
#pragma unroll
        for (int a = 0; a < 2; ++a)
#pragma unroll
            for (int b = 0; b < 2; ++b)
#pragma unroll
                for (int m = 0; m < 4; ++m)
#pragma unroll
                    for (int n = 0; n < 2; ++n) acc[a][b][m][n] = (f32x4){0.f, 0.f, 0.f, 0.f};
        if (nxt.pm != cur.pm) E.prep(nxt, wr, lane);
        cur = nxt; cA = nA; cB = nB; ++ui;
        if constexpr (ALIGN_EPI) { if (wr == 1) PG8_BAR; }
    }
    PG8_WAIT_V(0);
    if constexpr (!ALIGN_EPI) { if (wr == 0) PG8_BAR; }
    PG8_BAR;
    if constexpr (Epi::AFTER_DRAIN) { E.fused(acc, cur, wr, wc, fr, fq, lds, wid, lane); S.done(cur); }
#undef PG8_SA
#undef PG8_SB
#undef PG8_STAGE
#undef PG8_LDA
#undef PG8_LDB
#undef PG8_MMA
#undef PG8_WAIT_V
#undef PG8_WAIT_L
#undef PG8_BAR
#undef PG8_SCHED
}
}

#define GAS __attribute__((address_space(1)))
#define LAS __attribute__((address_space(3)))
typedef unsigned short bf16_t;
typedef short bf16x8 __attribute__((ext_vector_type(8)));
typedef float f32x4 __attribute__((ext_vector_type(4)));
typedef float f32x16 __attribute__((ext_vector_type(16)));
typedef unsigned u32x4 __attribute__((ext_vector_type(4)));
typedef unsigned u32x2 __attribute__((ext_vector_type(2)));
constexpr int NWAVES = 8, NTHR = 512;
constexpr int M = 16384, D = 1024, NP = 2560, DIN = 2568, DS = 512, NG = 32, NS = 64, NH = 4, DH = 128, DFF = 4096, NCHUNK = 256, CPB = 128, NITEM = 1024;
constexpr float EPS = 1e-6f;
constexpr size_t MiB = 1u << 20, KiB = 1024;
constexpr size_t WS_CTL = 0, CTL_ZERO_BYTES = 64 * KiB;
constexpr size_t WS_W = 1 * MiB, W_LSTRIDE = 24 * MiB;
constexpr size_t OFF_WIN = 0, OFF_WG = 5 * MiB, OFF_WGLU = 5 * MiB + 64 * KiB, OFF_WOUT = 6 * MiB, OFF_W1 = 8 * MiB, OFF_W2 = 16 * MiB;
constexpr size_t KTAB_G = 65 * 256;
constexpr size_t WS_KTAB = 49 * MiB, WS_A64 = 50 * MiB + 256 * KiB, WS_WST = 51 * MiB, WS_GT = 59 * MiB;
constexpr size_t T_KTAB = 0, T_A64 = WS_A64 - WS_KTAB, T_WST = WS_WST - WS_KTAB, T_GT = WS_GT - WS_KTAB, T_BYTES = 18 * MiB;
constexpr size_t WS_SLOTS = 67 * MiB, WS_SLOTS2 = 68 * MiB, WS_BCUM = 68 * MiB + 512 * KiB, WS_AARR = WS_BCUM + 256 * KiB, WS_PMAX = WS_AARR + 256 * KiB;
constexpr size_t WS_BLAST = WS_PMAX + 256 * KiB, WS_MAXG = WS_BLAST + 4 * KiB, WS_MST = WS_MAXG + 4 * KiB;
constexpr size_t WS_NLOC = 69 * MiB + 512 * KiB, WS_XLOC = 70 * MiB, WS_XPREV = 74 * MiB;
constexpr size_t WS_U2 = 76 * MiB, WS_QRAW = 92 * MiB, WS_Z = WS_QRAW, WS_KRAW = 108 * MiB, WS_VT = 124 * MiB, WS_ORAW = 140 * MiB, WS_HT = WS_ORAW, WS_QC = 156 * MiB, WS_KC = 172 * MiB;
constexpr size_t WS_DC = 188 * MiB, WS_YCAT = WS_DC, WS_XB = 220 * MiB, WS_CST = WS_XB, WS_H1 = 76 * MiB, WS_GATES = 253 * MiB, WS_END = 254 * MiB;
constexpr size_t WS_NST = WS_GATES + 512 * KiB;
static_assert(WS_CST + (size_t)NITEM * 16384 * 2 <= WS_GATES && WS_NST + 512 * KiB <= WS_END && WS_H1 + (size_t)M * DFF * 2 <= WS_XB && WS_BLAST + 12 * KiB <= WS_NLOC, "ws map");
constexpr int CW_BAR = 4096;
constexpr int RING_BYTES = 131072, LDS_BYTES = 160 * 1024, MISC_OFF = LDS_BYTES - 256;

#define RLX_AGENT __ATOMIC_RELAXED, __HIP_MEMORY_SCOPE_AGENT
#define LDS_WAIT() asm volatile("s_waitcnt lgkmcnt(0)" ::: "memory")
#define VM_WAIT() asm volatile("s_waitcnt vmcnt(0)" ::: "memory")
#define MFMA32(a, b, c) __builtin_amdgcn_mfma_f32_32x32x16_bf16((a), (b), (c), 0, 0, 0)
__device__ __forceinline__ float bf2f(unsigned b) { return __uint_as_float(b << 16); }
__device__ __forceinline__ unsigned f2bf(float f) { unsigned u = __float_as_uint(f); return (u + 0x7fffu + ((u >> 16) & 1u)) >> 16; }
__device__ __forceinline__ unsigned pk2(float lo, float hi) { return f2bf(lo) | (f2bf(hi) << 16); }
__device__ __forceinline__ float wave_sum(float v) {
#pragma unroll
    for (int o = 1; o < 64; o <<= 1) v += __shfl_xor(v, o);
    return v;
}
__device__ __forceinline__ float sigmoid_f(float x) { return 1.0f / (1.0f + __expf(-x)); }
__device__ __forceinline__ float logsigmoid_f(float x) { return fminf(x, 0.f) - log1pf(__expf(-fabsf(x))); }
__device__ __forceinline__ float gelu_tanh(float x) { const float u = 0.7978845608028654f * (x + 0.044715f * x * x * x); const float e = __expf(2.0f * u); const float th = 1.0f - 2.0f / (e + 1.0f); return 0.5f * x * (1.0f + th); }
__device__ __forceinline__ int crow(int reg, int hh) { return (reg & 3) + 8 * (reg >> 2) + 4 * hh; }
__device__ __forceinline__ float sum16(const float* p) { const f32x4 a = ((const f32x4*)p)[0], b = ((const f32x4*)p)[1], c = ((const f32x4*)p)[2], d = ((const f32x4*)p)[3];
    return ((a.x + a.y) + (a.z + a.w)) + ((b.x + b.y) + (b.z + b.w)) + ((c.x + c.y) + (c.z + c.w)) + ((d.x + d.y) + (d.z + d.w)); }
__device__ __forceinline__ float sum8(const float* p) { const f32x4 a = ((const f32x4*)p)[0], b = ((const f32x4*)p)[1]; return ((a.x + a.y) + (a.z + a.w)) + ((b.x + b.y) + (b.z + b.w)); }

#define XB_TMO      128
#define XB_XCNT(j)  (256  + 64 * (j))
#define XB_XSUB(j)  (1280 + 64 * (j))
#define XB_XGEN(j)  (2304 + 64 * (j))
#define XB_TOP      3328
#define XB_TOPGEN   3392
#define XCD_BAR_WORDS 3456
#define XB_SPIN_CAP (1u << 20)
__device__ __forceinline__ unsigned xb_ld(unsigned* p)              { return __hip_atomic_load(p, __ATOMIC_RELAXED, __HIP_MEMORY_SCOPE_AGENT); }
__device__ __forceinline__ unsigned xb_add(unsigned* p, unsigned v) { return __hip_atomic_fetch_add(p, v, __ATOMIC_RELAXED, __HIP_MEMORY_SCOPE_AGENT); }
__device__ __forceinline__ unsigned xb_xcc_id() { return (unsigned)__builtin_amdgcn_s_getreg((3 << 11) | 20) & 0xFu; }
#define XB_SPIN(cond, bar) do { unsigned _sp = 0; while (cond) { __builtin_amdgcn_s_sleep(1); \
    if ((++_sp & 255u) == 0u) { if (xb_ld(&(bar)[XB_TMO])) break; if (_sp > XB_SPIN_CAP) { atomicAdd(&(bar)[XB_TMO], 1u); break; } } } } while (0)
struct XcdBarrier { unsigned* bar; unsigned x; volatile LAS unsigned* st; };
__device__ __forceinline__ XcdBarrier xcd_barrier_post(unsigned* bar, volatile LAS unsigned* st) {
    XcdBarrier b; b.bar = bar; b.x = xb_xcc_id(); b.st = st;
    if (threadIdx.x == 0) (void)xb_add(&bar[XB_XCNT(b.x)], 1u);
    return b;
}
__device__ __forceinline__ void xcd_barrier_complete(unsigned* bar, unsigned x, unsigned& nloc, unsigned& nx) {
    const unsigned G = gridDim.x * gridDim.y * gridDim.z;
    unsigned sum, cnt, mine, sp = 0u;
    for (;;) {
        sum = 0u; cnt = 0u; mine = 0u;
#pragma unroll 1
        for (unsigned j = 0; j < 16; ++j) { const unsigned c = xb_ld(&bar[XB_XCNT(j)]); sum += c; cnt += (c > 0u) ? 1u : 0u; mine = (j == x) ? c : mine; }
        if (sum == G) break;
        __builtin_amdgcn_s_sleep(1);
        if ((++sp & 255u) == 0u) { if (xb_ld(&bar[XB_TMO])) break; if (sp > XB_SPIN_CAP) { atomicAdd(&bar[XB_TMO], 1u); break; } }
    }
    nloc = mine > 0u ? mine : 1u; nx = cnt > 0u ? cnt : 1u;
}
__device__ __forceinline__ void xcd_barrier(const XcdBarrier& b, unsigned* bar_in, bool leader) {
    asm volatile("s_waitcnt vmcnt(0)" ::: "memory");
    __syncthreads();
    if (leader) {
        unsigned* bar = bar_in;
        __builtin_amdgcn_s_waitcnt(0);
        unsigned nloc = b.st[0], nx = b.st[1];
        if (nloc == 0u) { xcd_barrier_complete(bar, b.x, nloc, nx); b.st[0] = nloc; b.st[1] = nx; }
        const unsigned old = xb_add(&bar[XB_XSUB(b.x)], 1u);
        const unsigned gen = old / nloc;
        if (old + 1u == (gen + 1u) * nloc) {
            __builtin_amdgcn_fence(__ATOMIC_RELEASE, "agent");
            asm volatile("s_waitcnt vmcnt(0)" ::: "memory");
            const unsigned og = xb_add(&bar[XB_TOP], 1u);
            const unsigned tg = og / nx;
            if (og + 1u == (tg + 1u) * nx) xb_add(&bar[XB_TOPGEN], 1u);
            else XB_SPIN(xb_ld(&bar[XB_TOPGEN]) == tg, bar);
            __builtin_amdgcn_fence(__ATOMIC_ACQUIRE, "agent");
            xb_add(&bar[XB_XGEN(b.x)], 1u);
            asm volatile("s_waitcnt vmcnt(0)" ::: "memory");
        } else {
            XB_SPIN(xb_ld(&bar[XB_XGEN(b.x)]) == gen, bar);
            __builtin_amdgcn_fence(__ATOMIC_ACQUIRE, "agent");
            asm volatile("s_waitcnt vmcnt(0)" ::: "memory");
        }
    }
    __syncthreads();
}

using pg8::Unit; using pg8::cvt_pk_bf16;
__device__ __forceinline__ float sum_fq(float v) {
    { auto r = __builtin_amdgcn_permlane16_swap(__float_as_uint(v), __float_as_uint(v), false, false); v = __uint_as_float(r[0]) + __uint_as_float(r[1]); }
    { auto r = __builtin_amdgcn_permlane32_swap(__float_as_uint(v), __float_as_uint(v), false, false); v = __uint_as_float(r[0]) + __uint_as_float(r[1]); }
    return v;
}
typedef const f32x4 (&AccC)[2][2][4][2];
typedef f32x4 (&AccM)[2][2][4][2];
__device__ __forceinline__ float sum16o(const unsigned char* base, unsigned off) { const f32x4 a = *(const f32x4*)(base + off), b = *(const f32x4*)(base + off + 16u), c = *(const f32x4*)(base + off + 32u), d = *(const f32x4*)(base + off + 48u);
    return ((a.x + a.y) + (a.z + a.w)) + ((b.x + b.y) + (b.z + b.w)) + ((c.x + c.y) + (c.z + c.w)) + ((d.x + d.y) + (d.z + d.w)); }
__device__ __forceinline__ float sum8o(const unsigned char* base, unsigned off) { const f32x4 a = *(const f32x4*)(base + off), b = *(const f32x4*)(base + off + 16u); return ((a.x + a.y) + (a.z + a.w)) + ((b.x + b.y) + (b.z + b.w)); }
constexpr int RSL_OFF = 131072;
template <int MODE> __device__ __forceinline__ void rs_prep(const Unit& u, int wr, int lane, unsigned char* ws, LAS float* rsl) {
#pragma unroll
    for (int hlf = 0; hlf < 2; ++hlf) {
        const unsigned row = (unsigned)(u.pm * 256 + hlf * 128 + wr * 64 + lane);
        float v;
        if (MODE == 3) v = rsqrtf(sum8o(ws, (unsigned)WS_SLOTS2 + row * 32u) * (1.0f / DS) + EPS);
        else { const float s = sum16o(ws, (unsigned)WS_SLOTS + row * 64u) * (1.0f / D) + EPS; v = MODE == 1 ? rsqrtf(s) : 1.0f / s; }
        rsl[hlf * 64 + lane] = v;
    }
    LDS_WAIT(); asm volatile("" ::: "memory");
}
__device__ __forceinline__ void epi_g1(AccC acc, const Unit& u, int wr, int wc, int fr, int fq, unsigned char* ws, const LAS float* rsl) {
    const unsigned row0 = (unsigned)(u.pm * 256 + wr * 64 + fr), colt = (unsigned)(u.pn * 256);
#pragma unroll
    for (int ai = 0; ai < 2; ++ai)
#pragma unroll
        for (int m = 0; m < 4; ++m) {
            const unsigned row = row0 + ai * 128 + m * 16;
            const float rs = rsl[ai * 64 + m * 16 + fr];
#pragma unroll
            for (int bj = 0; bj < 2; ++bj) {
                const unsigned c0 = colt + bj * 128 + wc * 32 + 8 * fq;
                const f32x4 v0 = acc[ai][bj][m][0] * rs, v1 = acc[ai][bj][m][1] * rs;
                u32x4 w; w.x = cvt_pk_bf16(v0[0], v0[1]); w.y = cvt_pk_bf16(v0[2], v0[3]); w.z = cvt_pk_bf16(v1[0], v1[1]); w.w = cvt_pk_bf16(v1[2], v1[3]);
                if (u.pn < 2) { const unsigned g = c0 >> 4, p0 = c0 & 15u; *(u32x4*)(ws + ((unsigned)WS_U2 + (g * (unsigned)M + row) * 32u + p0 * 2u)) = w; }
                else if (u.pn == 6 || u.pn == 7) {
                    const unsigned cv = c0 - 1536u, hh = cv >> 7, dv = cv & 127u, cid = row >> 6, s = row & 63u;
                    bf16_t* b = (bf16_t*)(ws + ((unsigned)WS_VT + ((cid * 4u + hh) * 8192u + (((s >> 4) * 128u + dv) * 16u + (s & 15u))) * 2u));
                    b[0] = (bf16_t)(w.x & 0xffffu); b[16] = (bf16_t)(w.x >> 16); b[32] = (bf16_t)(w.y & 0xffffu); b[48] = (bf16_t)(w.y >> 16);
                    b[64] = (bf16_t)(w.z & 0xffffu); b[80] = (bf16_t)(w.z >> 16); b[96] = (bf16_t)(w.w & 0xffffu); b[112] = (bf16_t)(w.w >> 16);
                } else {
                    const unsigned toff = u.pn < 4 ? (unsigned)WS_QRAW : (unsigned)WS_KRAW, cb = c0 - (u.pn < 4 ? 512u : 1024u);
                    *(u32x4*)(ws + (toff + (row * 512u + cb) * 2u)) = w;
                }
            }
        }
}
__device__ __forceinline__ void epi_g2(AccC acc, const Unit& u, int wr, int wc, int fr, int fq, unsigned char* ws, const float* bglu) {
    const unsigned row0 = (unsigned)(u.pm * 256 + wr * 64 + fr), colt = (unsigned)(u.pn * 256);
#pragma unroll
    for (int ai = 0; ai < 2; ++ai)
#pragma unroll
        for (int m = 0; m < 4; ++m) {
            const unsigned row = row0 + ai * 128 + m * 16; float ss = 0.f;
#pragma unroll
            for (int bj = 0; bj < 2; ++bj) {
                const unsigned c0 = colt + bj * 128 + wc * 32 + 8 * fq;
                const u32x4 zv = *(const u32x4*)(ws + ((unsigned)WS_Z + (row * 512u + c0) * 2u));
                const f32x4 b0 = *(const f32x4*)((const unsigned char*)bglu + c0 * 4u), b1 = *(const f32x4*)((const unsigned char*)bglu + c0 * 4u + 16u);
                const f32x4 a0 = acc[ai][bj][m][0] + b0, a1 = acc[ai][bj][m][1] + b1;
                float zz[8];
                zz[0] = bf2f(zv.x & 0xffffu) * sigmoid_f(a0[0]); zz[1] = bf2f(zv.x >> 16) * sigmoid_f(a0[1]);
                zz[2] = bf2f(zv.y & 0xffffu) * sigmoid_f(a0[2]); zz[3] = bf2f(zv.y >> 16) * sigmoid_f(a0[3]);
                zz[4] = bf2f(zv.z & 0xffffu) * sigmoid_f(a1[0]); zz[5] = bf2f(zv.z >> 16) * sigmoid_f(a1[1]);
                zz[6] = bf2f(zv.w & 0xffffu) * sigmoid_f(a1[2]); zz[7] = bf2f(zv.w >> 16) * sigmoid_f(a1[3]);
#pragma unroll
                for (int j = 0; j < 8; ++j) ss += zz[j] * zz[j];
                u32x4 w; w.x = cvt_pk_bf16(zz[0], zz[1]); w.y = cvt_pk_bf16(zz[2], zz[3]); w.z = cvt_pk_bf16(zz[4], zz[5]); w.w = cvt_pk_bf16(zz[6], zz[7]);
                *(u32x4*)(ws + ((unsigned)WS_YCAT + (row * 1024u + c0) * 2u)) = w;
            }
            ss = sum_fq(ss);
            if (fq == 0) *(float*)(ws + ((unsigned)WS_SLOTS2 + (row * 8u + (unsigned)(u.pn * 4 + wc)) * 4u)) = ss;
            if (m & 1) asm volatile("" ::: "memory");
        }
}
__device__ __forceinline__ void mid_g3(AccM acc, int fr, const LAS float* rsl) {
#pragma unroll
    for (int ai = 0; ai < 2; ++ai)
#pragma unroll
        for (int m = 0; m < 4; ++m) {
            const float r = rsl[ai * 64 + m * 16 + fr];
#pragma unroll
            for (int bj = 0; bj < 2; ++bj)
#pragma unroll
                for (int n = 0; n < 2; ++n) acc[ai][bj][m][n] = acc[ai][bj][m][n] * r;
            asm volatile("" ::: "memory");
        }
}
__device__ __forceinline__ void epi_res(AccC acc, const Unit& u, int wr, int wc, int fr, int fq, unsigned char* ws, const bf16_t* xold, bf16_t* xnew) {
    const unsigned row0 = (unsigned)(u.pm * 256 + wr * 64 + fr), colt = (unsigned)(u.pn * 256);
#pragma unroll
    for (int ai = 0; ai < 2; ++ai)
#pragma unroll
        for (int m = 0; m < 4; ++m) {
            const unsigned row = row0 + ai * 128 + m * 16; float ss = 0.f;
#pragma unroll
            for (int bj = 0; bj < 2; ++bj) {
                const unsigned o = (row * 1024u + colt + bj * 128 + wc * 32 + 8 * fq) * 2u;
                const u32x4 xv = *(const u32x4*)((const unsigned char*)xold + o);
                const f32x4 a0 = acc[ai][bj][m][0], a1 = acc[ai][bj][m][1];
                float x[8];
                x[0] = bf2f(xv.x & 0xffffu) + a0[0]; x[1] = bf2f(xv.x >> 16) + a0[1]; x[2] = bf2f(xv.y & 0xffffu) + a0[2]; x[3] = bf2f(xv.y >> 16) + a0[3];
                x[4] = bf2f(xv.z & 0xffffu) + a1[0]; x[5] = bf2f(xv.z >> 16) + a1[1]; x[6] = bf2f(xv.w & 0xffffu) + a1[2]; x[7] = bf2f(xv.w >> 16) + a1[3];
#pragma unroll
                for (int j = 0; j < 8; ++j) ss += x[j] * x[j];
                u32x4 w; w.x = cvt_pk_bf16(x[0], x[1]); w.y = cvt_pk_bf16(x[2], x[3]); w.z = cvt_pk_bf16(x[4], x[5]); w.w = cvt_pk_bf16(x[6], x[7]);
                *(u32x4*)((unsigned char*)xnew + o) = w;
            }
            ss = sum_fq(ss);
            if (fq == 0) *(float*)(ws + ((unsigned)WS_SLOTS + (row * 16u + (unsigned)(u.pn * 4 + wc)) * 4u)) = ss;
            if (m & 1) asm volatile("" ::: "memory");
        }
}
__device__ __forceinline__ void epi_g4(AccC acc, const Unit& u, int wr, int wc, int fr, int fq, unsigned char* ws, const LAS float* rsl) {
    const unsigned row0 = (unsigned)(u.pm * 256 + wr * 64 + fr), colt = (unsigned)(u.pn * 256);
#pragma unroll
    for (int ai = 0; ai < 2; ++ai)
#pragma unroll
        for (int m = 0; m < 4; ++m) {
            const unsigned row = row0 + ai * 128 + m * 16;
            const float r2 = rsl[ai * 64 + m * 16 + fr];
#pragma unroll
            for (int bj = 0; bj < 2; ++bj) {
                const unsigned c0 = colt + bj * 128 + wc * 32 + 8 * fq;
                f32x4 v0 = acc[ai][bj][m][0], v1 = acc[ai][bj][m][1];
#pragma unroll
                for (int j = 0; j < 4; ++j) { const float a = fmaxf(v0[j], 0.f), b = fmaxf(v1[j], 0.f); v0[j] = a * a * r2; v1[j] = b * b * r2; }
                u32x4 w; w.x = cvt_pk_bf16(v0[0], v0[1]); w.y = cvt_pk_bf16(v0[2], v0[3]); w.z = cvt_pk_bf16(v1[0], v1[1]); w.w = cvt_pk_bf16(v1[2], v1[3]);
                *(u32x4*)(ws + ((unsigned)WS_H1 + (row * (unsigned)DFF + c0) * 2u)) = w;
            }
        }
}
__device__ __forceinline__ void epi_oproj(AccM acc, const Unit& u, int wr, int wc, int fr, int fq, unsigned char* ws, const float* gnorm, const LAS float* rsl, LAS unsigned char* lds) {
    const unsigned row0 = (unsigned)(u.pm * 256 + wr * 64 + fr), colt = (unsigned)(u.pn * 256);
    LAS float* part = (LAS float*)lds;
#pragma unroll
    for (int ai = 0; ai < 2; ++ai)
#pragma unroll
        for (int m = 0; m < 4; ++m) {
            const unsigned row = row0 + ai * 128 + m * 16; const float rs = rsl[ai * 64 + m * 16 + fr];
#pragma unroll
            for (int bj = 0; bj < 2; ++bj) {
                const unsigned c0 = colt + bj * 128 + wc * 32 + 8 * fq;
                const u32x4 hv = *(const u32x4*)(ws + ((unsigned)WS_HT + (row * 512u + c0) * 2u));
                f32x4 a0 = acc[ai][bj][m][0], a1 = acc[ai][bj][m][1];
                a0[0] = sigmoid_f(a0[0] * rs) * bf2f(hv.x & 0xffffu); a0[1] = sigmoid_f(a0[1] * rs) * bf2f(hv.x >> 16); a0[2] = sigmoid_f(a0[2] * rs) * bf2f(hv.y & 0xffffu); a0[3] = sigmoid_f(a0[3] * rs) * bf2f(hv.y >> 16);
                a1[0] = sigmoid_f(a1[0] * rs) * bf2f(hv.z & 0xffffu); a1[1] = sigmoid_f(a1[1] * rs) * bf2f(hv.z >> 16); a1[2] = sigmoid_f(a1[2] * rs) * bf2f(hv.w & 0xffffu); a1[3] = sigmoid_f(a1[3] * rs) * bf2f(hv.w >> 16);
                acc[ai][bj][m][0] = a0; acc[ai][bj][m][1] = a1;
                float ss = (a0[0] * a0[0] + a0[1] * a0[1]) + (a0[2] * a0[2] + a0[3] * a0[3]) + (a1[0] * a1[0] + a1[1] * a1[1]) + (a1[2] * a1[2] + a1[3] * a1[3]);
                ss = sum_fq(ss);
                if (fq == 0) part[((ai * 128 + wr * 64 + m * 16 + fr) * 2 + bj) * 4 + wc] = ss;
            }
            if (m & 1) asm volatile("" ::: "memory");
        }
    asm volatile("s_waitcnt lgkmcnt(0)" ::: "memory"); __builtin_amdgcn_s_barrier(); asm volatile("" ::: "memory");
#pragma unroll
    for (int ai = 0; ai < 2; ++ai)
#pragma unroll
        for (int m = 0; m < 4; ++m) {
            const unsigned row = row0 + ai * 128 + m * 16;
#pragma unroll
            for (int bj = 0; bj < 2; ++bj) {
                const unsigned c0 = colt + bj * 128 + wc * 32 + 8 * fq;
                const f32x4 pp = *(const LAS f32x4*)(part + ((ai * 128 + wr * 64 + m * 16 + fr) * 2 + bj) * 4);
                const float rsn = rsqrtf(((pp.x + pp.y) + (pp.z + pp.w)) * (1.0f / DH) + EPS);
                const f32x4 g0 = *(const f32x4*)((const unsigned char*)gnorm + c0 * 4u), g1 = *(const f32x4*)((const unsigned char*)gnorm + c0 * 4u + 16u);
                const f32x4 v0 = acc[ai][bj][m][0] * rsn * g0, v1 = acc[ai][bj][m][1] * rsn * g1;
                u32x4 w; w.x = cvt_pk_bf16(v0[0], v0[1]); w.y = cvt_pk_bf16(v0[2], v0[3]); w.z = cvt_pk_bf16(v1[0], v1[1]); w.w = cvt_pk_bf16(v1[2], v1[3]);
                *(u32x4*)(ws + ((unsigned)WS_YCAT + (row * 1024u + 512u + c0) * 2u)) = w;
            }
        }
}
template <int KIND> struct EpiK {
    static constexpr bool AFTER_DRAIN = (KIND == 6);
    unsigned char* ws; const void* aux; void* xo; LAS float* rsl;
    __device__ __forceinline__ constexpr bool perm() const { return true; }
    __device__ __forceinline__ constexpr int mid_t() const { return KIND == 3 ? 8 : -1; }
    __device__ __forceinline__ void prep(const Unit& u, int wr, int lane) const { if constexpr (KIND == 1 || KIND == 3 || KIND == 4) rs_prep<KIND>(u, wr, lane, ws, rsl); else if constexpr (KIND == 6) rs_prep<1>(u, wr, lane, ws, rsl); }
    __device__ __forceinline__ void mid(AccM acc, const Unit& u, int wr, int wc, int fr, int fq) const { if constexpr (KIND == 3) mid_g3(acc, fr, rsl); }
    __device__ __forceinline__ void operator()(AccC acc, const Unit& u, int wr, int wc, int fr, int fq) const {
        if constexpr (KIND == 1) epi_g1(acc, u, wr, wc, fr, fq, ws, rsl);
        else if constexpr (KIND == 2) epi_g2(acc, u, wr, wc, fr, fq, ws, (const float*)aux);
        else if constexpr (KIND == 4) epi_g4(acc, u, wr, wc, fr, fq, ws, rsl);
        else if constexpr (KIND == 3 || KIND == 5) epi_res(acc, u, wr, wc, fr, fq, ws, (const bf16_t*)aux, (bf16_t*)xo);
    }
    __device__ __forceinline__ void fused(AccM acc, const Unit& u, int wr, int wc, int fr, int fq, LAS unsigned char* lds, int wid, int lane) const {
        if constexpr (KIND == 6) epi_oproj(acc, u, wr, wc, fr, fq, ws, (const float*)aux, rsl, lds);
    }
};

struct Args { const float* in[24]; float* out; unsigned char* ws; int ph_lo, ph_hi, flags, pad; };
struct Env {
    volatile LAS unsigned* pt;
    __device__ __forceinline__ unsigned long long ptr(int i) const { const unsigned lo = pt[2 * i], hi = pt[2 * i + 1];
        return ((unsigned long long)(unsigned)__builtin_amdgcn_readfirstlane((int)hi) << 32) | (unsigned)__builtin_amdgcn_readfirstlane((int)lo); }
    __device__ __forceinline__ const float* in(int i) const { return (const float*)ptr(i); }
    __device__ __forceinline__ float* out() const { return (float*)ptr(24); }
    __device__ __forceinline__ unsigned char* ws() const { return (unsigned char*)ptr(25); }
    __device__ __forceinline__ unsigned char* tab(int l) const { return l == 0 ? ws() + WS_KTAB : (unsigned char*)out() + 32 * MiB; }
};

__device__ __forceinline__ void p0_transpose_item(const float* W, int ldw, int K, int nblk, const float* kscale, int kslen, bf16_t* WT, LAS float* scr, int item, int lane) {
    const int kb = item / nblk, nb = item % nblk, k0 = 64 * kb, n0 = 64 * nb;
    const int lr = lane >> 4, lc = (lane & 15) * 4;
    f32x4 v[16];
#pragma unroll
    for (int i = 0; i < 16; ++i) v[i] = *(const f32x4*)(W + (size_t)(k0 + 4 * i + lr) * ldw + n0 + lc);
#pragma unroll
    for (int i = 0; i < 16; ++i) { const int kk = 4 * i + lr; const float sc = (k0 + kk < kslen) ? kscale[k0 + kk] : 1.0f; LAS float* d = scr + kk * 65 + lc;
        d[0] = v[i].x * sc; d[1] = v[i].y * sc; d[2] = v[i].z * sc; d[3] = v[i].w * sc; }
    LDS_WAIT(); asm volatile("" ::: "memory");
    const int c = lane & 7;
#pragma unroll
    for (int j = 0; j < 8; ++j) { const int n = (lane >> 3) + 8 * j; const LAS float* s = scr + (8 * c) * 65 + n;
        u32x4 o; o.x = pk2(s[0 * 65], s[1 * 65]); o.y = pk2(s[2 * 65], s[3 * 65]); o.z = pk2(s[4 * 65], s[5 * 65]); o.w = pk2(s[6 * 65], s[7 * 65]);
        *(u32x4*)(WT + (size_t)(n0 + n) * K + k0 + 8 * c) = o; }
    LDS_WAIT(); asm volatile("" ::: "memory");
}
__device__ __forceinline__ void p0_weights(const Env& A, int l, LAS unsigned char* lds, int wave, int lane, int gw, int NGW) {
    unsigned char* const ws = A.ws(); const float* const i1 = A.in(1); const float* const i2 = A.in(2); const float* const i11 = A.in(11); const float* const i13 = A.in(13);
    const float* const i19 = A.in(19); const float* const i20 = A.in(20); const float* const i21 = A.in(21); const float* const i22 = A.in(22);
    LAS float* scr = (LAS float*)(lds + wave * 16640);
    constexpr int I_IN = 16 * 40, I_GLU = 8 * 8, I_OUT = 16 * 16, I_1 = 16 * 64, I_2 = 64 * 16, I_G = 16, I_L = I_IN + I_GLU + I_OUT + I_1 + I_2 + I_G;
    unsigned char* wb = ws + WS_W + (size_t)l * W_LSTRIDE;
    for (int it = gw; it < I_L; it += NGW) {
        int r = it;
        if (r < I_IN) { p0_transpose_item(i2 + (size_t)l * D * DIN, DIN, D, 40, i1 + l * D, D, (bf16_t*)(wb + OFF_WIN), scr, r, lane); continue; } r -= I_IN;
        if (r < I_GLU) { p0_transpose_item(i11 + (size_t)l * DS * DS, DS, DS, 8, nullptr, 0, (bf16_t*)(wb + OFF_WGLU), scr, r, lane); continue; } r -= I_GLU;
        if (r < I_OUT) { p0_transpose_item(i19 + (size_t)l * D * D, D, D, 16, i13 + l * DS, DS, (bf16_t*)(wb + OFF_WOUT), scr, r, lane); continue; } r -= I_OUT;
        if (r < I_1) { p0_transpose_item(i21 + (size_t)l * D * DFF, DFF, D, 64, i20 + l * D, D, (bf16_t*)(wb + OFF_W1), scr, r, lane); continue; } r -= I_1;
        if (r < I_2) { p0_transpose_item(i22 + (size_t)l * DFF * D, D, DFF, 16, nullptr, 0, (bf16_t*)(wb + OFF_W2), scr, r, lane); continue; } r -= I_2;
        { const int k = 64 * r + lane; bf16_t* wg = (bf16_t*)(wb + OFF_WG);
#pragma unroll
          for (int j = 0; j < 32; ++j) { const float v = j < 8 ? i1[l * D + k] * i2[(size_t)l * D * DIN + (size_t)k * DIN + 2560 + j] : 0.f; wg[j * 1024 + k] = (bf16_t)f2bf(v); } }
    }
}
__device__ __forceinline__ void rpass(const float* src, bf16_t* XB, unsigned char* ws, int wave, int lane) {
    const int gw = blockIdx.x * NWAVES + wave, NGW = gridDim.x * NWAVES;
    float* slots = (float*)(ws + WS_SLOTS);
    for (int m = gw; m < M; m += 2 * NGW) {
        const int m2 = m + NGW; const bool has2 = m2 < M;
        const f32x4* xr = (const f32x4*)(src + (size_t)m * D) + lane; const f32x4* xr2 = (const f32x4*)(src + (size_t)(has2 ? m2 : m) * D) + lane;
        f32x4 v[4], w[4]; float s = 0.f, s2 = 0.f;
#pragma unroll
        for (int j = 0; j < 4; ++j) { v[j] = xr[64 * j]; w[j] = xr2[64 * j]; }
#pragma unroll
        for (int j = 0; j < 4; ++j) { s += (v[j].x * v[j].x + v[j].y * v[j].y) + (v[j].z * v[j].z + v[j].w * v[j].w); s2 += (w[j].x * w[j].x + w[j].y * w[j].y) + (w[j].z * w[j].z + w[j].w * w[j].w); }
        s = wave_sum(s); s2 = wave_sum(s2);
        u32x2* o8 = (u32x2*)(XB + (size_t)m * D) + lane;
#pragma unroll
        for (int j = 0; j < 4; ++j) { u32x2 q; q.x = pk2(v[j].x, v[j].y); q.y = pk2(v[j].z, v[j].w); o8[64 * j] = q; }
        if (lane < 16) slots[(size_t)m * 16 + lane] = lane == 0 ? s : 0.f;
        if (has2) {
            u32x2* o9 = (u32x2*)(XB + (size_t)m2 * D) + lane;
#pragma unroll
            for (int j = 0; j < 4; ++j) { u32x2 q; q.x = pk2(w[j].x, w[j].y); q.y = pk2(w[j].z, w[j].w); o9[64 * j] = q; }
            if (lane < 16) slots[(size_t)m2 * 16 + lane] = lane == 0 ? s2 : 0.f;
        }
    }
}
__device__ __forceinline__ void build_tables(const Env& A, int l, int g, int j, LAS unsigned char* lds, int tid) {
    LAS float* pwr = (LAS float*)lds;
    LAS float* pwi = pwr + 65 * 64;
    LAS float* bbr = pwi + 65 * 64;
    LAS float* bbi = bbr + 1024;
    LAS float* cr = bbi + 1024;
    LAS float* ci = cr + 1024;
    const int lg = l * NG + g;
    unsigned char* const ws = A.ws(); const float* const i3 = A.in(3); const float* const i4 = A.in(4); const float* const i5 = A.in(5); const float* const i6 = A.in(6);
    const float* const i7 = A.in(7); const float* const i8 = A.in(8); const float* const i9 = A.in(9);
    unsigned char* const tb = A.tab(l);
    bf16_t* KTAB = (bf16_t*)(tb + T_KTAB) + (size_t)g * KTAB_G;
    bf16_t* WST = (bf16_t*)(tb + T_WST) + (size_t)g * 128 * 1024;
    bf16_t* GT = (bf16_t*)(tb + T_GT) + (size_t)g * 1024 * 128;
    float* A64 = (float*)(tb + T_A64);
    for (int e = tid; e < 65 * 64; e += NTHR) {
        const int tau = e >> 6, n = e & 63;
        const float are = i3[lg * NS + n], aim = i4[lg * NS + n], dt = __expf(i5[lg]);
        const float mg = __expf((float)tau * (are * dt));
        float rev = (float)tau * (aim * dt) * 0.15915494309189535f; rev -= floorf(rev);
        pwr[e] = mg * __builtin_amdgcn_cosf(rev); pwi[e] = mg * __builtin_amdgcn_sinf(rev);
    }
    for (int e = tid; e < 1024; e += NTHR) {
        const int n = e >> 4;
        const float are = i3[lg * NS + n], aim = i4[lg * NS + n], dt = expf(i5[lg]);
        const float mag = expf(are * dt), abr = mag * cosf(aim * dt), abi = mag * sinf(aim * dt);
        const float den = are * are + aim * aim, zr = abr - 1.0f;
        const float sr = (zr * are + abi * aim) / den, si = (abi * are - zr * aim) / den;
        const float br = i6[(size_t)lg * 1024 + e], bi = i7[(size_t)lg * 1024 + e];
        bbr[e] = sr * br - si * bi; bbi[e] = sr * bi + si * br;
    }
    if (j == 0 && tid < 64) {
        const int n = tid;
        const float are = i3[lg * NS + n], aim = i4[lg * NS + n], dt = expf(i5[lg]);
        const float mag = expf(are * dt);
        double pr = (double)(mag * cosf(aim * dt)), pi = (double)(mag * sinf(aim * dt));
#pragma unroll
        for (int s = 0; s < 6; ++s) { const double t = pr * pr - pi * pi; pi = 2.0 * pr * pi; pr = t; }
        A64[(g * 64 + n) * 2] = (float)pr; A64[(g * 64 + n) * 2 + 1] = (float)pi;
    }
    for (int i = tid; i < 1024; i += NTHR) { cr[i] = i8[(size_t)lg * 1024 + i]; ci[i] = i9[(size_t)lg * 1024 + i]; }
    __syncthreads();
    {
        const int pair = tid >> 2, nq = tid & 3, tau = 8 * j + (pair >> 4), p = pair & 15;
        float acc[16];
#pragma unroll
        for (int q = 0; q < 16; ++q) acc[q] = 0.f;
#pragma unroll 2
        for (int n = 16 * nq; n < 16 * nq + 16; ++n) {
            const float c_r = cr[p * 64 + n], c_i = ci[p * 64 + n], p_r = pwr[tau * 64 + n], p_i = pwi[tau * 64 + n];
            const float xr = c_r * p_r - c_i * p_i, xi = c_r * p_i + c_i * p_r;
#pragma unroll
            for (int q4 = 0; q4 < 4; ++q4) { const f32x4 br = *(const LAS f32x4*)(bbr + n * 16 + 4 * q4), bi = *(const LAS f32x4*)(bbi + n * 16 + 4 * q4);
                acc[4 * q4] += xr * br.x - xi * bi.x; acc[4 * q4 + 1] += xr * br.y - xi * bi.y; acc[4 * q4 + 2] += xr * br.z - xi * bi.z; acc[4 * q4 + 3] += xr * br.w - xi * bi.w; }
        }
#pragma unroll
        for (int q = 0; q < 16; ++q) { acc[q] += __shfl_xor(acc[q], 1); acc[q] += __shfl_xor(acc[q], 2); }
        if (nq == 0) { u32x4 o0, o1; o0.x = pk2(acc[0], acc[1]); o0.y = pk2(acc[2], acc[3]); o0.z = pk2(acc[4], acc[5]); o0.w = pk2(acc[6], acc[7]);
            o1.x = pk2(acc[8], acc[9]); o1.y = pk2(acc[10], acc[11]); o1.z = pk2(acc[12], acc[13]); o1.w = pk2(acc[14], acc[15]);
            *(u32x4*)(KTAB + (tau + 1) * 256 + p * 16) = o0; *(u32x4*)(KTAB + (tau + 1) * 256 + p * 16 + 8) = o1; }
    }
    if (j == 0) for (int e = tid; e < 256; e += NTHR) KTAB[e] = 0;
    for (int e = tid; e < 2048; e += NTHR) {
        const int s = e >> 5, np = 16 * j + ((e >> 1) & 15), q0 = (e & 1) * 8, n = np & 63, im = np >> 6;
        const float p_r = pwr[(63 - s) * 64 + n], p_i = pwi[(63 - s) * 64 + n]; float v[8];
#pragma unroll
        for (int jj = 0; jj < 8; ++jj) { const float b_r = bbr[n * 16 + q0 + jj], b_i = bbi[n * 16 + q0 + jj]; v[jj] = im ? (p_r * b_i + p_i * b_r) : (p_r * b_r - p_i * b_i); }
        u32x4 o; o.x = pk2(v[0], v[1]); o.y = pk2(v[2], v[3]); o.z = pk2(v[4], v[5]); o.w = pk2(v[6], v[7]);
        *(u32x4*)(WST + (size_t)((s * 128 + np) * 16 + q0)) = o;
    }
    for (int e = tid; e < 2048; e += NTHR) {
        const int ks = e >> 8, tpl = (e >> 1) & 127, t = 8 * j + (tpl >> 4), p = tpl & 15, np0 = ks * 16 + (e & 1) * 8; float v[8];
#pragma unroll
        for (int jj = 0; jj < 8; ++jj) { const int np = np0 + jj, n = np & 63; const float p_r = pwr[(t + 1) * 64 + n], p_i = pwi[(t + 1) * 64 + n], c_r = cr[p * 64 + n], c_i = ci[p * 64 + n];
            v[jj] = (np >> 6) ? -(c_r * p_i + c_i * p_r) : (c_r * p_r - c_i * p_i); }
        u32x4 o; o.x = pk2(v[0], v[1]); o.y = pk2(v[2], v[3]); o.z = pk2(v[4], v[5]); o.w = pk2(v[6], v[7]);
        *(u32x4*)(GT + (size_t)((ks * 1024 + t * 16 + p) * 16 + (e & 1) * 8)) = o;
    }
    __syncthreads();
}

constexpr int USTR = 2048 + 16;
__device__ __forceinline__ void s5a_item(unsigned char* ws, const unsigned char* tb, int g, int rb, LAS unsigned char* lds, int tid, int wave, int lane) {
    const unsigned char* U2b = (const unsigned char*)((const bf16_t*)(ws + WS_U2) + ((size_t)g * M + (size_t)rb * 2048) * 16);
    const bf16_t* WST = (const bf16_t*)(tb + T_WST) + (size_t)g * 128 * 1024;
    float* XLOC = (float*)(ws + WS_XLOC);
    {   u32x4 t[8];
#pragma unroll
        for (int i = 0; i < 8; ++i) t[i] = *(const u32x4*)(U2b + (unsigned)((tid + i * NTHR) * 16));
#pragma unroll
        for (int i = 0; i < 8; ++i) { const int idx = tid + i * NTHR; *(LAS u32x4*)(lds + (idx >> 7) * USTR + (idx & 127) * 16) = t[i]; }
    }
    __syncthreads();
    const int r = lane & 31, hh = lane >> 5, nt = wave & 3, kh = wave >> 2;
    f32x16 acc; for (int i = 0; i < 16; ++i) acc[i] = 0.f;
    const LAS unsigned char* ap = lds + r * USTR + kh * 1024 + hh * 16;
    const bf16_t* bp = WST + (unsigned)(((kh * 32) * 128 + nt * 32 + r) * 16 + 8 * hh);
#pragma unroll 8
    for (int ks = 0; ks < 32; ++ks) { const bf16x8 a = *(const LAS bf16x8*)(ap + ks * 32), b = *(const bf16x8*)(bp + (unsigned)(ks * 2048)); acc = MFMA32(a, b, acc); }
    __syncthreads();
    LAS float* part = (LAS float*)lds + nt * 1024;
    if (kh == 1) {
#pragma unroll
        for (int reg = 0; reg < 16; ++reg) part[crow(reg, hh) * 32 + r] = acc[reg];
    }
    __syncthreads();
    if (kh == 0) {
#pragma unroll
        for (int reg = 0; reg < 16; ++reg) { const int row = crow(reg, hh), cid = rb * 32 + row; XLOC[((size_t)cid * 32 + g) * 128 + nt * 32 + r] = acc[reg] + part[row * 32 + r]; }
    }
    __syncthreads();
}
__device__ __forceinline__ void gates_wave(unsigned char* ws, const bf16_t* XB, int l, int it0, int nit, int stride, int lane_in) {
    int lane = lane_in; asm volatile("" : "+v"(lane)); __builtin_assume(lane >= 0 && lane < 64);
    const bf16_t* WG = (const bf16_t*)(ws + WS_W + (size_t)l * W_LSTRIDE + OFF_WG);
    float wg[8][16];
#pragma unroll
    for (int j = 0; j < 8; ++j) { const u32x4 a = *(const u32x4*)(WG + (unsigned)(j * 1024 + 16 * lane)), b = *(const u32x4*)(WG + (unsigned)(j * 1024 + 16 * lane + 8));
        wg[j][0] = bf2f(a.x & 0xffffu); wg[j][1] = bf2f(a.x >> 16); wg[j][2] = bf2f(a.y & 0xffffu); wg[j][3] = bf2f(a.y >> 16); wg[j][4] = bf2f(a.z & 0xffffu); wg[j][5] = bf2f(a.z >> 16); wg[j][6] = bf2f(a.w & 0xffffu); wg[j][7] = bf2f(a.w >> 16);
        wg[j][8] = bf2f(b.x & 0xffffu); wg[j][9] = bf2f(b.x >> 16); wg[j][10] = bf2f(b.y & 0xffffu); wg[j][11] = bf2f(b.y >> 16); wg[j][12] = bf2f(b.z & 0xffffu); wg[j][13] = bf2f(b.z >> 16); wg[j][14] = bf2f(b.w & 0xffffu); wg[j][15] = bf2f(b.w >> 16); }
    for (int it = it0; it < nit; it += stride) {
        const int rowb = it * 8;
        float v[64];
        u32x4 xa[8], xb2[8];
#pragma unroll
        for (int i = 0; i < 8; ++i) { xa[i] = *(const u32x4*)(XB + (unsigned)((rowb + i) * 1024 + 16 * lane)); xb2[i] = *(const u32x4*)(XB + (unsigned)((rowb + i) * 1024 + 16 * lane + 8)); }
#pragma unroll
        for (int i = 0; i < 8; ++i) {
            float x[16];
            x[0] = bf2f(xa[i].x & 0xffffu); x[1] = bf2f(xa[i].x >> 16); x[2] = bf2f(xa[i].y & 0xffffu); x[3] = bf2f(xa[i].y >> 16); x[4] = bf2f(xa[i].z & 0xffffu); x[5] = bf2f(xa[i].z >> 16); x[6] = bf2f(xa[i].w & 0xffffu); x[7] = bf2f(xa[i].w >> 16);
            x[8] = bf2f(xb2[i].x & 0xffffu); x[9] = bf2f(xb2[i].x >> 16); x[10] = bf2f(xb2[i].y & 0xffffu); x[11] = bf2f(xb2[i].y >> 16); x[12] = bf2f(xb2[i].z & 0xffffu); x[13] = bf2f(xb2[i].z >> 16); x[14] = bf2f(xb2[i].w & 0xffffu); x[15] = bf2f(xb2[i].w >> 16);
#pragma unroll
            for (int j = 0; j < 8; ++j) { float s = 0.f;
#pragma unroll
                for (int k = 0; k < 16; ++k) s += x[k] * wg[j][k];
                v[i * 8 + j] = s; }
        }
#pragma unroll
        for (int c = 32; c >= 1; c >>= 1) {
            const bool up = (lane & c) != 0;
#pragma unroll
            for (int m = 0; m < c; ++m) { const float keep = up ? v[m + c] : v[m], send = up ? v[m] : v[m + c]; v[m] = keep + __shfl_xor(send, c); }
        }
        const int row = rowb + (lane >> 3);
        const float rs = rsqrtf(sum16((const float*)(ws + WS_SLOTS) + (size_t)row * 16) * (1.0f / D) + EPS);
        ((float*)(ws + WS_GATES))[(size_t)rowb * 8 + lane] = v[0] * rs;
    }
}
constexpr int KTS = 72, MLA_LDS = 128 * KTS * 2;
__device__ __forceinline__ void mla_wave(const Env& A, int l, int cid, int h, LAS unsigned char* wl, int lane_in) {
    int lane = lane_in; asm volatile("" : "+v"(lane)); __builtin_assume(lane >= 0 && lane < 64);
    unsigned char* const ws = A.ws(); const float* const i14 = A.in(14); const float* const i15 = A.in(15); const float* const i16 = A.in(16); const float* const i17 = A.in(17);
    const bf16_t* QRAW = (const bf16_t*)(ws + WS_QRAW); const bf16_t* KRAW = (const bf16_t*)(ws + WS_KRAW);
    const int item = cid * 4 + h, row0 = cid * 64, r = lane & 31, hh = lane >> 5;
    bf16_t* QC = (bf16_t*)(ws + WS_QC) + (size_t)item * 8192; bf16_t* KC = (bf16_t*)(ws + WS_KC) + (size_t)item * 8192;
    LAS bf16_t* kT = (LAS bf16_t*)wl;
    float wt;
    {
        const float* G = (const float*)(ws + WS_GATES) + (size_t)(row0 + lane) * 8;
        const float ig = G[h] + i16[l * NH + h], lf = logsigmoid_f(G[4 + h] + i17[l * NH + h]);
        float bc = lf;
#pragma unroll
        for (int o = 1; o < 64; o <<= 1) { const float v = __shfl_up(bc, o); if (lane >= o) bc += v; }
        const float a = ig - bc; float pm = a;
#pragma unroll
        for (int o = 1; o < 64; o <<= 1) { const float v = __shfl_up(pm, o); if (lane >= o) pm = fmaxf(pm, v); }
        const float amax = __shfl(pm, 63), blast = __shfl(bc, 63);
        ((float*)(ws + WS_BCUM))[item * 64 + lane] = bc; ((float*)(ws + WS_AARR))[item * 64 + lane] = a; ((float*)(ws + WS_PMAX))[item * 64 + lane] = pm;
        if (lane == 0) { ((float*)(ws + WS_BLAST))[item] = blast; ((float*)(ws + WS_MAXG))[item] = blast + amax; }
        wt = __expf(a - amax);
    }
    {
        const int c = h * DH + 2 * lane;
        const float* cw = i14 + l * 4 * 1024; const float* cb = i15 + l * 1024;
        float wq0[4], wq1[4], wk0[4], wk1[4];
#pragma unroll
        for (int jj = 0; jj < 4; ++jj) { wq0[jj] = cw[jj * 1024 + c]; wq1[jj] = cw[jj * 1024 + c + 1]; wk0[jj] = cw[jj * 1024 + 512 + c]; wk1[jj] = cw[jj * 1024 + 512 + c + 1]; }
        const float bq0 = cb[c], bq1 = cb[c + 1], bk0 = cb[512 + c], bk1 = cb[512 + c + 1];
        const float kscale = 0.08838834764831845f;
        const bool first = (cid & (CPB - 1)) == 0;
        unsigned hq[3] = {0u, 0u, 0u}, hk[3] = {0u, 0u, 0u};
        if (!first) {
#pragma unroll
            for (int i = 0; i < 3; ++i) { hq[i] = *(const unsigned*)(QRAW + (unsigned)((row0 - 3 + i) * 512 + c)); hk[i] = *(const unsigned*)(KRAW + (unsigned)((row0 - 3 + i) * 512 + c)); }
        }
        float q0a = bf2f(hq[0] & 0xffffu), q0b = bf2f(hq[1] & 0xffffu), q0c = bf2f(hq[2] & 0xffffu), q1a = bf2f(hq[0] >> 16), q1b = bf2f(hq[1] >> 16), q1c = bf2f(hq[2] >> 16);
        float k0a = bf2f(hk[0] & 0xffffu), k0b = bf2f(hk[1] & 0xffffu), k0c = bf2f(hk[2] & 0xffffu), k1a = bf2f(hk[0] >> 16), k1b = bf2f(hk[1] >> 16), k1c = bf2f(hk[2] >> 16);
        unsigned uqn[8], ukn[8];
#pragma unroll
        for (int i = 0; i < 8; ++i) { uqn[i] = *(const unsigned*)(QRAW + (unsigned)((row0 + i) * 512 + c)); ukn[i] = *(const unsigned*)(KRAW + (unsigned)((row0 + i) * 512 + c)); }
        for (int t0 = 0; t0 < 64; t0 += 8) {
            unsigned uq[8], uk[8];
#pragma unroll
            for (int i = 0; i < 8; ++i) { uq[i] = uqn[i]; uk[i] = ukn[i]; }
            if (t0 + 8 < 64) {
#pragma unroll
                for (int i = 0; i < 8; ++i) { uqn[i] = *(const unsigned*)(QRAW + (unsigned)((row0 + t0 + 8 + i) * 512 + c)); ukn[i] = *(const unsigned*)(KRAW + (unsigned)((row0 + t0 + 8 + i) * 512 + c)); }
            }
#pragma unroll
            for (int i = 0; i < 8; ++i) {
                const int t = t0 + i;
                const float q0d = bf2f(uq[i] & 0xffffu), q1d = bf2f(uq[i] >> 16), k0d = bf2f(uk[i] & 0xffffu), k1d = bf2f(uk[i] >> 16);
                const float aq0 = bq0 + wq0[0] * q0a + wq0[1] * q0b + wq0[2] * q0c + wq0[3] * q0d, aq1 = bq1 + wq1[0] * q1a + wq1[1] * q1b + wq1[2] * q1c + wq1[3] * q1d;
                const float ak0 = bk0 + wk0[0] * k0a + wk0[1] * k0b + wk0[2] * k0c + wk0[3] * k0d, ak1 = bk1 + wk1[0] * k1a + wk1[1] * k1b + wk1[2] * k1c + wk1[3] * k1d;
                q0a = q0b; q0b = q0c; q0c = q0d; q1a = q1b; q1b = q1c; q1c = q1d; k0a = k0b; k0b = k0c; k0c = k0d; k1a = k1b; k1b = k1c; k1c = k1d;
                const float qv0 = aq0 * sigmoid_f(aq0), qv1 = aq1 * sigmoid_f(aq1), kv0 = ak0 * sigmoid_f(ak0) * kscale, kv1 = ak1 * sigmoid_f(ak1) * kscale;
                *(unsigned*)(QC + (unsigned)(((lane >> 3) * 64 + t) * 16 + 2 * (lane & 7))) = pk2(qv0, qv1);
                const unsigned kb = pk2(kv0, kv1);
                *(unsigned*)(KC + (unsigned)(((lane >> 3) * 64 + t) * 16 + 2 * (lane & 7))) = kb;
                const float w_t = __shfl(wt, t);
                kT[(2 * lane) * KTS + t] = (bf16_t)f2bf(w_t * bf2f(kb & 0xffffu)); kT[(2 * lane + 1) * KTS + t] = (bf16_t)f2bf(w_t * bf2f(kb >> 16));
            }
        }
    }
    LDS_WAIT(); asm volatile("" ::: "memory");
    {
        const bf16_t* VT = (const bf16_t*)(ws + WS_VT) + (size_t)item * 128 * 64;
        bf16_t* dc = (bf16_t*)(ws + WS_DC) + (size_t)item * 16384;
        bf16x8 vb[4][4];
#pragma unroll
        for (int nt = 0; nt < 4; ++nt)
#pragma unroll
            for (int ks = 0; ks < 4; ++ks) vb[nt][ks] = *(const bf16x8*)(VT + (unsigned)((ks * 128 + nt * 32 + r) * 16 + 8 * hh));
#pragma unroll
        for (int nt = 0; nt < 4; ++nt) {
            bf16x8 b[4];
#pragma unroll
            for (int ks = 0; ks < 4; ++ks) b[ks] = vb[nt][ks];
#pragma unroll
            for (int mt = 0; mt < 4; ++mt) {
                f32x16 acc; for (int i = 0; i < 16; ++i) acc[i] = 0.f;
#pragma unroll
                for (int ks = 0; ks < 4; ++ks) acc = MFMA32(*(const LAS bf16x8*)(kT + (mt * 32 + r) * KTS + ks * 16 + 8 * hh), b[ks], acc);
#pragma unroll
                for (int g4 = 0; g4 < 4; ++g4) { u32x2 w; w.x = pk2(acc[4 * g4], acc[4 * g4 + 1]); w.y = pk2(acc[4 * g4 + 2], acc[4 * g4 + 3]);
                    *(u32x2*)(dc + (unsigned)(((mt * 2 + (g4 >> 1)) * 128 + nt * 32 + r) * 16 + (g4 & 1) * 8 + 4 * hh)) = w; }
            }
        }
        float* NLOC = (float*)(ws + WS_NLOC) + (size_t)item * DH;
#pragma unroll
        for (int half = 0; half < 2; ++half) { const int dk = lane + 64 * half; float s = 0.f;
#pragma unroll
            for (int o = 0; o < 8; ++o) { const u32x4 q = *(const LAS u32x4*)(kT + dk * KTS + 8 * o);
                s += (bf2f(q.x & 0xffffu) + bf2f(q.x >> 16)) + (bf2f(q.y & 0xffffu) + bf2f(q.y >> 16)) + (bf2f(q.z & 0xffffu) + bf2f(q.z >> 16)) + (bf2f(q.w & 0xffffu) + bf2f(q.w >> 16)); }
            NLOC[dk] = s; }
    }
    LDS_WAIT(); asm volatile("" ::: "memory");
}

__device__ __forceinline__ void m2_scans(const Env& A, int l, LAS unsigned char* lds, int tid, int wave, int lane) {
    unsigned char* const ws = A.ws();
    const float* BLAST = (const float*)(ws + WS_BLAST); const float* MAXG = (const float*)(ws + WS_MAXG); float* MST = (float*)(ws + WS_MST);
    const int nb = gridDim.x, nbC = nb >= 2 ? nb / 2 : 1, bid = blockIdx.x;
    if (bid < nbC || nb < 2) {
        const bf16_t* DC = (const bf16_t*)(ws + WS_DC); bf16_t* CST = (bf16_t*)(ws + WS_CST);
        constexpr int NPAIR = NH * 2 * DH * DH / 2;
        for (int it = bid * NTHR + tid; it < NPAIR; it += nbC * NTHR) {
            const int bh = it >> 13, idx = (it & 8191) * 2, b = bh >> 2, h = bh & 3;
            float C0 = 0.f, C1 = 0.f, mp = 0.f;
            for (int c0 = 0; c0 < CPB; c0 += 16) {
                unsigned v[16]; float bl[16], mg[16];
#pragma unroll
                for (int u = 0; u < 16; ++u) { const int item = (b * CPB + c0 + u) * 4 + h; v[u] = *(const unsigned*)(DC + (size_t)item * 16384 + idx); bl[u] = BLAST[item]; mg[u] = MAXG[item]; }
#pragma unroll
                for (int u = 0; u < 16; ++u) {
                    const int item = (b * CPB + c0 + u) * 4 + h;
                    *(unsigned*)(CST + (size_t)item * 16384 + idx) = pk2(C0, C1);
                    if (idx == 0) MST[item] = mp;
                    const float mn = fmaxf(bl[u] + mp, mg[u]);
                    const float d1 = __expf(bl[u] + mp - mn), d2 = __expf(mg[u] - mn);
                    C0 = d1 * C0 + d2 * bf2f(v[u] & 0xffffu); C1 = d1 * C1 + d2 * bf2f(v[u] >> 16); mp = mn;
                }
            }
        }
    }
    if (bid >= nbC || nb < 2) {
        const int ob = nb < 2 ? 0 : bid - nbC, nob = nb < 2 ? 1 : nb - nbC;
        const float* NLOC = (const float*)(ws + WS_NLOC); float* NST = (float*)(ws + WS_NST);
        const float* XLOC = (const float*)(ws + WS_XLOC); bf16_t* XPREV = (bf16_t*)(ws + WS_XPREV); const float* A64 = (const float*)(A.tab(l) + T_A64);
        constexpr int NN = NH * 2 * DH, NX = 2 * NG * NS;
        for (int it = ob * NTHR + tid; it < NN + NX; it += nob * NTHR) {
            if (it < NN) {
                const int bh = it >> 7, idx = it & 127, b = bh >> 2, h = bh & 3;
                float Cp = 0.f, mp = 0.f;
                for (int c0 = 0; c0 < CPB; c0 += 16) {
                    float v[16], bl[16], mg[16];
#pragma unroll
                    for (int u = 0; u < 16; ++u) { const int item = (b * CPB + c0 + u) * 4 + h; v[u] = NLOC[(size_t)item * DH + idx]; bl[u] = BLAST[item]; mg[u] = MAXG[item]; }
#pragma unroll
                    for (int u = 0; u < 16; ++u) {
                        const int item = (b * CPB + c0 + u) * 4 + h;
                        NST[(size_t)item * DH + idx] = Cp;
                        const float mn = fmaxf(bl[u] + mp, mg[u]);
                        Cp = __expf(bl[u] + mp - mn) * Cp + __expf(mg[u] - mn) * v[u]; mp = mn;
                    }
                }
            } else {
                const int e = it - NN, b = e >> 11, g = (e >> 6) & 31, n = e & 63;
                const float ar = A64[(g * 64 + n) * 2], ai = A64[(g * 64 + n) * 2 + 1]; float xr = 0.f, xi = 0.f;
                for (int c0 = 0; c0 < CPB; c0 += 16) {
                    float lr[16], li[16];
#pragma unroll
                    for (int u = 0; u < 16; ++u) { const size_t base = ((size_t)(b * CPB + c0 + u) * 32 + g) * 128; lr[u] = XLOC[base + n]; li[u] = XLOC[base + 64 + n]; }
#pragma unroll
                    for (int u = 0; u < 16; ++u) { const size_t base = ((size_t)(b * CPB + c0 + u) * 32 + g) * 128;
                        XPREV[base + n] = (bf16_t)f2bf(xr); XPREV[base + 64 + n] = (bf16_t)f2bf(xi);
                        const float nr = ar * xr - ai * xi + lr[u], ni = ar * xi + ai * xr + li[u]; xr = nr; xi = ni; }
                }
            }
        }
    }
}

constexpr int S5C_KT = 32 * USTR, S5C_XP = S5C_KT + 65 * 512, XPSTR = 256 + 16;
static_assert(S5C_XP + 32 * XPSTR <= RING_BYTES, "S5c LDS");
__device__ __forceinline__ void s5c_item(const Env& A, int l, int g, int rb, LAS unsigned char* lds, int tid, int wave, int lane) {
    unsigned char* const ws = A.ws(); const float* const i10 = A.in(10);
    const unsigned char* U2b = (const unsigned char*)((const bf16_t*)(ws + WS_U2) + ((size_t)g * M + (size_t)rb * 2048) * 16);
    const unsigned char* const tb = A.tab(l);
    const unsigned char* KTb = (const unsigned char*)((const bf16_t*)(tb + T_KTAB) + (size_t)g * KTAB_G);
    const bf16_t* XPREV = (const bf16_t*)(ws + WS_XPREV);
    const bf16_t* GT = (const bf16_t*)(tb + T_GT) + (size_t)g * 1024 * 128;
    bf16_t* Z = (bf16_t*)(ws + WS_Z);
    {
        u32x4 t[8];
#pragma unroll
        for (int i = 0; i < 8; ++i) t[i] = *(const u32x4*)(U2b + (unsigned)((tid + i * NTHR) * 16));
#pragma unroll
        for (int i = 0; i < 8; ++i) { const int idx = tid + i * NTHR; *(LAS u32x4*)(lds + (idx >> 7) * USTR + (idx & 127) * 16) = t[i]; }
        u32x4 k[5]; const u32x4 xp = *(const u32x4*)(XPREV + ((size_t)(rb * 32 + (tid >> 4)) * 32 + g) * 128 + (tid & 15) * 8);
#pragma unroll
        for (int i = 0; i < 5; ++i) { const int idx = tid + i * NTHR; k[i] = idx < 2080 ? *(const u32x4*)(KTb + (unsigned)(idx * 16)) : (u32x4){0u, 0u, 0u, 0u}; }
#pragma unroll
        for (int i = 0; i < 5; ++i) { const int idx = tid + i * NTHR; if (idx < 2080) *(LAS u32x4*)(lds + S5C_KT + idx * 16) = k[i]; }
        *(LAS u32x4*)(lds + S5C_XP + (tid >> 4) * XPSTR + (tid & 15) * 16) = xp;
    }
    __syncthreads();
    const int r = lane & 31, hh = lane >> 5, tsub = r >> 4, p = r & 15;
    int tt[4]; tt[0] = wave; tt[1] = 15 - wave; tt[2] = 16 + wave; tt[3] = 31 - wave;
    f32x16 acc[4];
#pragma unroll
    for (int j = 0; j < 4; ++j) for (int i = 0; i < 16; ++i) acc[j][i] = 0.f;
    const LAS unsigned char* ua = lds + r * USTR + hh * 16;
    const LAS unsigned char* kb = lds + S5C_KT + p * 32 + hh * 16;
#pragma unroll 2
    for (int s = 0; s < 64; ++s) {
        const bf16x8 u = *(const LAS bf16x8*)(ua + s * 32);
#pragma unroll
        for (int j = 0; j < 4; ++j) if (s <= 2 * tt[j] + 1) { const int tau1 = 2 * tt[j] + tsub - s + 1; const bf16x8 k = *(const LAS bf16x8*)(kb + tau1 * 512); acc[j] = MFMA32(k, u, acc[j]); }
    }
    const LAS unsigned char* xa = lds + S5C_XP + r * XPSTR + hh * 16;
#pragma unroll
    for (int ks = 0; ks < 8; ++ks) {
        const bf16x8 x = *(const LAS bf16x8*)(xa + ks * 32);
#pragma unroll
        for (int j = 0; j < 4; ++j) { const bf16x8 gfr = *(const bf16x8*)(GT + (unsigned)((ks * 1024 + tt[j] * 32 + r) * 16 + 8 * hh)); acc[j] = MFMA32(gfr, x, acc[j]); }
    }
#pragma unroll
    for (int j = 0; j < 4; ++j) {
#pragma unroll
        for (int g4 = 0; g4 < 4; ++g4) {
            const int t = 2 * tt[j] + (g4 >> 1), p0 = 8 * (g4 & 1) + 4 * hh;
            const f32x4 dd = *(const f32x4*)(i10 + (l * NG + g) * 16 + p0);
            const u32x2 uv = *(const LAS u32x2*)(lds + r * USTR + (t * 16 + p0) * 2);
            const float y0 = acc[j][4 * g4] + dd.x * bf2f(uv.x & 0xffffu), y1 = acc[j][4 * g4 + 1] + dd.y * bf2f(uv.x >> 16), y2 = acc[j][4 * g4 + 2] + dd.z * bf2f(uv.y & 0xffffu), y3 = acc[j][4 * g4 + 3] + dd.w * bf2f(uv.y >> 16);
            u32x2 o; o.x = pk2(gelu_tanh(y0), gelu_tanh(y1)); o.y = pk2(gelu_tanh(y2), gelu_tanh(y3));
            *(u32x2*)(Z + (unsigned)(((rb * 32 + r) * 64 + t) * 512 + g * 16 + p0)) = o;
        }
    }
    __syncthreads();
}
constexpr int PSTR = 72, MLC_LDS = 8192;
__device__ __forceinline__ void mlc_wave(const Env& A, int l, int item, int mt, LAS unsigned char* wl, int lane_in) {
    int lane = lane_in; asm volatile("" : "+v"(lane)); __builtin_assume(lane >= 0 && lane < 64);
    unsigned char* const ws = A.ws();
    const int cid = item >> 2, h = item & 3, row0 = cid * 64 + mt * 32, r = lane & 31, hh = lane >> 5;
    const bf16_t* QC = (const bf16_t*)(ws + WS_QC) + (size_t)item * 8192;
    const bf16_t* KC = (const bf16_t*)(ws + WS_KC) + (size_t)item * 8192;
    const bf16_t* VT = (const bf16_t*)(ws + WS_VT) + (size_t)item * 128 * 64;
    const bf16_t* CST = (const bf16_t*)(ws + WS_CST) + (size_t)item * 16384;
    bf16_t* HT = (bf16_t*)(ws + WS_HT) + (size_t)(row0 + r) * 512 + h * DH;
    LAS bf16_t* P = (LAS bf16_t*)wl;
    LAS float* al = (LAS float*)(wl + 4608);
    const float mst = ((const float*)(ws + WS_MST))[item];
    al[lane] = ((const float*)(ws + WS_AARR))[item * 64 + lane];
    const int tl = mt * 32 + r;
    const float Mt = fmaxf(mst, ((const float*)(ws + WS_PMAX))[item * 64 + tl]);
    const float sc_t = __expf(mst - Mt), emt_t = __expf(-((const float*)(ws + WS_BCUM))[item * 64 + tl] - Mt);
    bf16x8 qf[8], cb[2][8];
#pragma unroll
    for (int ks = 0; ks < 8; ++ks) qf[ks] = *(const bf16x8*)(QC + (unsigned)((ks * 64 + mt * 32 + r) * 16 + 8 * hh));
#pragma unroll
    for (int ks = 0; ks < 8; ++ks) cb[0][ks] = *(const bf16x8*)(CST + (unsigned)((ks * 128 + r) * 16 + 8 * hh));
    LDS_WAIT(); asm volatile("" ::: "memory");
    f32x16 accQ[4];
#pragma unroll
    for (int i = 0; i < 16; ++i) { accQ[0][i] = 0.f; accQ[1][i] = 0.f; accQ[2][i] = 0.f; accQ[3][i] = 0.f; }
#pragma unroll
    for (int nt = 0; nt < 4; ++nt) {
        if (nt < 3) {
#pragma unroll
            for (int ks = 0; ks < 8; ++ks) cb[(nt + 1) & 1][ks] = *(const bf16x8*)(CST + (unsigned)((ks * 128 + (nt + 1) * 32 + r) * 16 + 8 * hh));
        } else {
#pragma unroll
            for (int ks = 0; ks < 8; ++ks) cb[0][ks] = *(const bf16x8*)(KC + (unsigned)((ks * 64 + r) * 16 + 8 * hh));
        }
#pragma unroll
        for (int ks = 0; ks < 8; ++ks) accQ[nt] = MFMA32(cb[nt & 1][ks], qf[ks], accQ[nt]);
    }
    float den2;
    {
        const float* NST = (const float*)(ws + WS_NST) + (size_t)item * DH; float s = 0.f;
#pragma unroll
        for (int ks = 0; ks < 8; ++ks) { const f32x4 n0 = *(const f32x4*)(NST + ks * 16 + 8 * hh), n1 = *(const f32x4*)(NST + ks * 16 + 8 * hh + 4);
            s += bf2f((unsigned short)qf[ks][0]) * n0.x + bf2f((unsigned short)qf[ks][1]) * n0.y + bf2f((unsigned short)qf[ks][2]) * n0.z + bf2f((unsigned short)qf[ks][3]) * n0.w
               + bf2f((unsigned short)qf[ks][4]) * n1.x + bf2f((unsigned short)qf[ks][5]) * n1.y + bf2f((unsigned short)qf[ks][6]) * n1.z + bf2f((unsigned short)qf[ks][7]) * n1.w; }
        auto q2 = __builtin_amdgcn_permlane32_swap(__float_as_uint(s), __float_as_uint(s), false, false); den2 = __uint_as_float(q2[0]) + __uint_as_float(q2[1]);
    }
    float rsum = 0.f;
#pragma unroll
    for (int st = 0; st < 2; ++st) if (st <= mt) {
        f32x16 accS; for (int i = 0; i < 16; ++i) accS[i] = 0.f;
        if (st < mt) {
#pragma unroll
            for (int ks = 0; ks < 8; ++ks) cb[(st + 1) & 1][ks] = *(const bf16x8*)(KC + (unsigned)((ks * 64 + (st + 1) * 32 + r) * 16 + 8 * hh));
        }
#pragma unroll
        for (int ks = 0; ks < 8; ++ks) accS = MFMA32(cb[st & 1][ks], qf[ks], accS);
#pragma unroll
        for (int g4 = 0; g4 < 4; ++g4) {
            float pv[4];
#pragma unroll
            for (int e = 0; e < 4; ++e) { const int s = st * 32 + 8 * g4 + 4 * hh + e; const float w = (s <= tl) ? __expf(al[s] - Mt) : 0.f; pv[e] = accS[4 * g4 + e] * w; rsum += pv[e]; }
            u32x2 o; o.x = pk2(pv[0], pv[1]); o.y = pk2(pv[2], pv[3]);
            *(LAS u32x2*)(P + r * PSTR + st * 32 + 8 * g4 + 4 * hh) = o;
        }
    }
    { auto q = __builtin_amdgcn_permlane32_swap(__float_as_uint(rsum), __float_as_uint(rsum), false, false); rsum = __uint_as_float(q[0]) + __uint_as_float(q[1]); }
    const float inv_t = 1.0f / fmaxf(fabsf(rsum + sc_t * den2), emt_t);
#pragma unroll
    for (int nt = 0; nt < 4; ++nt)
#pragma unroll
        for (int reg = 0; reg < 16; ++reg) accQ[nt][reg] *= sc_t;
    LDS_WAIT(); asm volatile("" ::: "memory");
    const int nks = 2 * (mt + 1);
    bf16x8 va[2][4];
#pragma unroll
    for (int nt = 0; nt < 4; ++nt) va[0][nt] = *(const bf16x8*)(VT + (unsigned)((nt * 32 + r) * 16 + 8 * hh));
#pragma unroll
    for (int ks = 0; ks < 4; ++ks) if (ks < nks) {
        const bf16x8 pb = *(const LAS bf16x8*)(P + r * PSTR + ks * 16 + 8 * hh);
        if (ks + 1 < nks) {
#pragma unroll
            for (int nt = 0; nt < 4; ++nt) va[(ks + 1) & 1][nt] = *(const bf16x8*)(VT + (unsigned)(((ks + 1) * 128 + nt * 32 + r) * 16 + 8 * hh));
        }
#pragma unroll
        for (int nt = 0; nt < 4; ++nt) accQ[nt] = MFMA32(va[ks & 1][nt], pb, accQ[nt]);
    }
#pragma unroll
    for (int nt = 0; nt < 4; ++nt)
#pragma unroll
        for (int g4 = 0; g4 < 4; ++g4) {
            u32x2 o; o.x = pk2(accQ[nt][4 * g4] * inv_t, accQ[nt][4 * g4 + 1] * inv_t); o.y = pk2(accQ[nt][4 * g4 + 2] * inv_t, accQ[nt][4 * g4 + 3] * inv_t);
            *(u32x2*)(HT + (unsigned)(nt * 32 + 8 * g4 + 4 * hh)) = o;
        }
    LDS_WAIT(); asm volatile("" ::: "memory");
}
__device__ __forceinline__ void final_norm(const Env& A, int wave, int lane) {
    const int gw = blockIdx.x * NWAVES + wave, NGW = gridDim.x * NWAVES;
    unsigned char* const ws = A.ws();
    const float* slots = (const float*)(ws + WS_SLOTS); const bf16_t* XB = (const bf16_t*)(ws + WS_XB); float* const xo = A.out();
    const f32x4 g0 = *((const f32x4*)A.in(23) + 2 * lane), g1 = *((const f32x4*)A.in(23) + 2 * lane + 1), g2 = *((const f32x4*)A.in(23) + 128 + 2 * lane), g3 = *((const f32x4*)A.in(23) + 128 + 2 * lane + 1);
    for (int m = gw; m < M; m += NGW) {
        const float rs = rsqrtf(sum16(slots + (size_t)m * 16) * (1.0f / D) + EPS);
        const u32x4 a = *((const u32x4*)(XB + (size_t)m * D) + lane), b = *((const u32x4*)(XB + (size_t)m * D) + 64 + lane);
        f32x4* o = (f32x4*)(xo + (size_t)m * D);
        o[2 * lane] = (f32x4){bf2f(a.x & 0xffffu), bf2f(a.x >> 16), bf2f(a.y & 0xffffu), bf2f(a.y >> 16)} * rs * g0;
        o[2 * lane + 1] = (f32x4){bf2f(a.z & 0xffffu), bf2f(a.z >> 16), bf2f(a.w & 0xffffu), bf2f(a.w >> 16)} * rs * g1;
        o[128 + 2 * lane] = (f32x4){bf2f(b.x & 0xffffu), bf2f(b.x >> 16), bf2f(b.y & 0xffffu), bf2f(b.y >> 16)} * rs * g2;
        o[128 + 2 * lane + 1] = (f32x4){bf2f(b.z & 0xffffu), bf2f(b.z >> 16), bf2f(b.w & 0xffffu), bf2f(b.w >> 16)} * rs * g3;
    }
}

constexpr int N_PHASES = 18;
#ifndef MK_PHMASK
#define MK_PHMASK 0x3ff
#endif
#define PHEN(i) (((MK_PHMASK) >> (i)) & 1)
__global__ void __launch_bounds__(NTHR, 2) mega_fwd(Args args) {
    extern __shared__ __attribute__((aligned(16))) unsigned char lds_raw[];
    LAS unsigned char* lds = (LAS unsigned char*)lds_raw;
    volatile LAS unsigned* MISC = (volatile LAS unsigned*)(lds + MISC_OFF);
    volatile LAS unsigned* PT = (volatile LAS unsigned*)(lds + MISC_OFF - 256);
    if (threadIdx.x < 64) MISC[threadIdx.x] = 0u;
    if (threadIdx.x == 0) {
#pragma unroll
        for (int i = 0; i < 24; ++i) { const unsigned long long v = (unsigned long long)args.in[i]; PT[2 * i] = (unsigned)v; PT[2 * i + 1] = (unsigned)(v >> 32); }
        { const unsigned long long v = (unsigned long long)args.out; PT[48] = (unsigned)v; PT[49] = (unsigned)(v >> 32); }
        { const unsigned long long v = (unsigned long long)args.ws; PT[50] = (unsigned)v; PT[51] = (unsigned)(v >> 32); }
    }
    __syncthreads();
    Env A; A.pt = PT;
    const int wave0 = __builtin_amdgcn_readfirstlane(threadIdx.x >> 6);
    XcdBarrier bar = xcd_barrier_post((unsigned*)(args.ws + WS_CTL) + CW_BAR, MISC + 8);
    const int lo = args.ph_lo, hi = args.ph_hi, flags = args.flags;
#ifndef MK_REP_PH
#define MK_REP_PH -1
#endif
#ifndef MK_REP_SUB
#define MK_REP_SUB 0
#endif
#define SUBREP(code) for (int rep_ = 0; rep_ < ((MK_REP_SUB) == (code) ? 2 : 1); ++rep_)
    for (int ph = lo, rep = 0; ph < hi; (ph == MK_REP_PH && rep == 0) ? (rep = 1) : (rep = 0, ++ph)) {
#ifdef MK_TS_PH
        if (blockIdx.x == 0 && wave0 == 0) { const unsigned long long t_ = __builtin_amdgcn_s_memrealtime(); __hip_atomic_store((unsigned long long*)(A.ws() + 40960) + ph, t_, __ATOMIC_RELAXED, __HIP_MEMORY_SCOPE_AGENT); }
#endif
        int wave = wave0; asm volatile("" : "+s"(wave));
        int lane; asm volatile("v_mbcnt_lo_u32_b32 %0, -1, 0\n\tv_mbcnt_hi_u32_b32 %0, -1, %0" : "=v"(lane));
        __builtin_assume(lane >= 0 && lane < 64); __builtin_assume(wave >= 0 && wave < 8);
        const int tid = wave * 64 + lane;
        if (ph > lo || rep) xcd_barrier(bar, (unsigned*)(A.ws() + WS_CTL) + CW_BAR, tid == 0);
#ifdef MK_XBAR
        if (ph == 5) for (int xb_ = 0; xb_ < MK_XBAR; ++xb_) xcd_barrier(bar, (unsigned*)(A.ws() + WS_CTL) + CW_BAR, tid == 0);
#endif
        if (ph == 0) { if (PHEN(0)) {
            SUBREP(6) p0_weights(A, 0, lds, wave, lane, blockIdx.x * NWAVES + wave, gridDim.x * NWAVES);
            SUBREP(7) rpass(A.in(0), (bf16_t*)A.out(), A.ws(), wave, lane);
            __syncthreads();
            SUBREP(8) for (int it = blockIdx.x; it < 512; it += gridDim.x) build_tables(A, it >> 8, (it >> 3) & 31, it & 7, lds, tid); }
        } else if (ph == 17) {
            if (PHEN(9)) final_norm(A, wave, lane);
        } else {
            const int l = (ph - 1) >> 3, k = (ph - 1) & 7;
            unsigned char* const ws = A.ws();
            if (k == 1) { if (PHEN(2)) {
                SUBREP(1) for (int it = blockIdx.x; it < 256; it += gridDim.x) s5a_item(ws, A.tab(l), it & 31, it >> 5, lds, tid, wave, lane);
                if ((wave & 1) == 0) SUBREP(2) for (int it = blockIdx.x * 4 + (wave >> 1); it < NITEM; it += gridDim.x * 4) mla_wave(A, l, it >> 2, it & 3, lds + wave * MLA_LDS, lane); }
            } else if (k == 2) {
                if (PHEN(3)) m2_scans(A, l, lds, tid, wave, lane);
            } else if (k == 3) { if (PHEN(4)) {
                SUBREP(3) for (int it = blockIdx.x; it < 256; it += gridDim.x) s5c_item(A, l, it & 31, it >> 5, lds, tid, wave, lane);
                SUBREP(4) for (int it = blockIdx.x * NWAVES + wave; it < 2 * NITEM; it += gridDim.x * NWAVES) mlc_wave(A, l, it >> 1, it & 1, lds + wave * MLC_LDS, lane); }
            } else {
#define LAUNDER_TD() int wv = wave0; asm volatile("" : "+s"(wv)); int ln; asm volatile("v_mbcnt_lo_u32_b32 %0, -1, 0\n\tv_mbcnt_hi_u32_b32 %0, -1, %0" : "=v"(ln)); __builtin_assume(ln >= 0 && ln < 64); __builtin_assume(wv >= 0 && wv < 8); const int td = wv * 64 + ln
                unsigned char* const wb = ws + WS_W + (size_t)l * W_LSTRIDE;
                if (k == 0) { if (PHEN(1)) {
                    pg8::Gemm g{(const bf16_t*)A.out(), (const bf16_t*)(wb + OFF_WIN), M, 2048, D}; pg8::StaticOrder S; S.init(M, 2048, gridDim.x, blockIdx.x);
                    LAUNDER_TD(); EpiK<1> E{ws, nullptr, nullptr, (LAS float*)(lds + RSL_OFF + wv * 512)};
                    pg8::gemm_phase<EpiK<1>, pg8::StaticOrder, true, true>(lds, g, S, E, td);
                    SUBREP(9) gates_wave(ws, (const bf16_t*)A.out(), l, blockIdx.x * NWAVES + wave, M / 8, gridDim.x * NWAVES, lane); }
                } else if (k == 4) { if (PHEN(5)) {
                    const int nbA = gridDim.x / 2;
                    if ((int)blockIdx.x < nbA) {
                        pg8::Gemm g{(const bf16_t*)(ws + WS_Z), (const bf16_t*)(wb + OFF_WGLU), M, DS, DS}; pg8::StaticOrder S; S.init(M, DS, nbA, blockIdx.x);
                        LAUNDER_TD(); EpiK<2> E{ws, A.in(12) + l * DS, nullptr, nullptr};
                        SUBREP(10) pg8::gemm_phase<EpiK<2>, pg8::StaticOrder, true, true>(lds, g, S, E, td);
                        if (l == 0) { __syncthreads(); p0_weights(A, 1, lds, wave, lane, blockIdx.x * NWAVES + wave, nbA * NWAVES); }
                    } else {
                        pg8::Gemm g{(const bf16_t*)A.out(), (const bf16_t*)(wb + OFF_WIN) + (size_t)2048 * D, M, DS, D}; pg8::StaticOrder S; S.init(M, DS, (int)gridDim.x - nbA, (int)blockIdx.x - nbA);
                        LAUNDER_TD(); EpiK<6> E{ws, A.in(18) + l * 512, nullptr, (LAS float*)(lds + RSL_OFF + wv * 512)};
                        SUBREP(11) pg8::gemm_phase<EpiK<6>, pg8::StaticOrder, true, true>(lds, g, S, E, td);
                    } }
                } else if (k == 5) { if (PHEN(6)) {
                    pg8::Gemm g{(const bf16_t*)(ws + WS_YCAT), (const bf16_t*)(wb + OFF_WOUT), M, D, D}; pg8::StaticOrder S; S.init(M, D, gridDim.x, blockIdx.x);
                    void* const xo = (void*)A.out();
#ifdef MK_REP_G3
                    { EpiK<3> E0{ws, (void*)(ws + WS_H1), (void*)(ws + WS_H1 + 32 * MiB), (LAS float*)(lds + RSL_OFF + wave * 512)}; int wv0 = wave0; asm volatile("" : "+s"(wv0)); int ln0; asm volatile("v_mbcnt_lo_u32_b32 %0, -1, 0\n\tv_mbcnt_hi_u32_b32 %0, -1, %0" : "=v"(ln0)); __builtin_assume(ln0 >= 0 && ln0 < 64); __builtin_assume(wv0 >= 0 && wv0 < 8);
                      pg8::gemm_phase<EpiK<3>, pg8::StaticOrder, true, true>(lds, g, S, E0, wv0 * 64 + ln0); xcd_barrier(bar, (unsigned*)(ws + WS_CTL) + CW_BAR, tid == 0); }
#endif
                    LAUNDER_TD(); EpiK<3> E{ws, xo, xo, (LAS float*)(lds + RSL_OFF + wv * 512)};
                    pg8::gemm_phase<EpiK<3>, pg8::StaticOrder, true, true>(lds, g, S, E, td); }
                } else if (k == 6) { if (PHEN(7)) {
                    pg8::Gemm g{(const bf16_t*)A.out(), (const bf16_t*)(wb + OFF_W1), M, DFF, D}; pg8::StaticOrder S; S.init(M, DFF, gridDim.x, blockIdx.x);
                    LAUNDER_TD(); EpiK<4> E{ws, nullptr, nullptr, (LAS float*)(lds + RSL_OFF + wv * 512)};
                    pg8::gemm_phase<EpiK<4>, pg8::StaticOrder, true, true>(lds, g, S, E, td); }
                } else { if (PHEN(8)) {
                    pg8::Gemm g{(const bf16_t*)(ws + WS_H1), (const bf16_t*)(wb + OFF_W2), M, D, DFF}; pg8::StaticOrder S; S.init(M, D, gridDim.x, blockIdx.x);
                    void* const xo = (void*)A.out();
                    LAUNDER_TD(); EpiK<5> E{ws, xo, l == 1 ? (void*)(ws + WS_XB) : xo, nullptr};
                    pg8::gemm_phase<EpiK<5>, pg8::StaticOrder, true, true>(lds, g, S, E, td); }
                }
            }
        }
    }
#ifdef MK_TS_PH
    {
        if (blockIdx.x == 0 && wave0 == 0) {
            unsigned long long* TS = (unsigned long long*)(A.ws() + 40960);
            const unsigned long long tn = __builtin_amdgcn_s_memrealtime();
            const unsigned long long ta = __hip_atomic_load(TS + (MK_TS_PH == 99 ? 0 : MK_TS_PH), __ATOMIC_RELAXED, __HIP_MEMORY_SCOPE_AGENT), tb = (MK_TS_PH + 1 < hi) ? __hip_atomic_load(TS + (MK_TS_PH == 99 ? 1 : MK_TS_PH + 1), __ATOMIC_RELAXED, __HIP_MEMORY_SCOPE_AGENT) : tn;
#if MK_TS_PH == 99
            const unsigned long long target = tn + (tn - __hip_atomic_load(TS + lo, __ATOMIC_RELAXED, __HIP_MEMORY_SCOPE_AGENT));
#else
            const unsigned long long target = tn + 4ull * (tb - ta);
#endif
            while (__builtin_amdgcn_s_memrealtime() < target) __builtin_amdgcn_s_sleep(8);
        }
    }
#endif
}

extern "C" void kernel_launch(void* const* d_in, const int* in_sizes, int n_in, void* d_out, int out_size, void* d_ws, size_t ws_size, hipStream_t stream) {
    static int grid = 0;
    if (grid == 0) {
        if (n_in != 24 || out_size != M * D || ws_size < WS_END) { fprintf(stderr, "kernel_launch: unexpected problem shape (n_in %d out %d ws %zu)\n", n_in, out_size, ws_size); grid = -1; return; }
        int dev = 0, cus = 0, per_cu = 0;
        if (hipGetDevice(&dev) != hipSuccess || hipDeviceGetAttribute(&cus, hipDeviceAttributeMultiprocessorCount, dev) != hipSuccess) { grid = -1; return; }
        if (hipFuncSetAttribute((const void*)mega_fwd, hipFuncAttributeMaxDynamicSharedMemorySize, LDS_BYTES) != hipSuccess) { fprintf(stderr, "kernel_launch: hipFuncSetAttribute failed\n"); grid = -1; return; }
        if (hipOccupancyMaxActiveBlocksPerMultiprocessor(&per_cu, (const void*)mega_fwd, NTHR, LDS_BYTES) != hipSuccess || per_cu < 1) { fprintf(stderr, "kernel_launch: occupancy query says %d\n", per_cu); per_cu = 1; }
        (void)hipGetLastError();
        grid = cus;
    }
    if (grid < 0) return;
    (void)hipMemsetAsync((char*)d_ws + WS_CTL, 0, CTL_ZERO_BYTES, stream);
    Args a{};
    for (int i = 0; i < 24; ++i) a.in[i] = (const float*)d_in[i];
    a.out = (float*)d_out; a.ws = (unsigned char*)d_ws; a.flags = 0; a.pad = 0;
#ifndef MK_SPLIT
    a.ph_lo = 0; a.ph_hi = N_PHASES;
    hipLaunchKernelGGL(mega_fwd, dim3(grid), dim3(NTHR), LDS_BYTES, stream, a);
#else
    for (int ph = 0; ph < N_PHASES; ++ph) { a.ph_lo = ph; a.ph_hi = ph + 1; hipLaunchKernelGGL(mega_fwd, dim3(grid), dim3(NTHR), LDS_BYTES, stream, a); }
#endif
}
```
